# Optimizing an MI355X kernel written in HIP

```python
import math
import jax, jax.numpy as jnp
from jax import lax
import numpy as np

D_MODEL = 1024
BATCH = 8
SEQ = 4096
DEPTH = 1

MEM_LEN = 256
HEAD_DIM = 64
LRU_WIDTH = 512
LRU_BLOCKS = 8
LRU_BLOCK = LRU_WIDTH // LRU_BLOCKS
CONV_WIDTH = 4
LRU_C = 8.0
SWA_Q_HEADS = 4
SWA_KV_HEADS = 2
SWA_GROUP = SWA_Q_HEADS // SWA_KV_HEADS
SWA_WIDTH = SWA_Q_HEADS * HEAD_DIM
SWA_KV_WIDTH = SWA_KV_HEADS * HEAD_DIM
WINDOW = 128
BLOCK = 128
XATTN_HEADS = 4
XATTN_WIDTH = XATTN_HEADS * HEAD_DIM
D_MIX = LRU_WIDTH + SWA_WIDTH + XATTN_WIDTH
IN_SPLITS = (LRU_WIDTH, LRU_WIDTH, SWA_WIDTH, SWA_KV_WIDTH, SWA_KV_WIDTH, SWA_WIDTH, XATTN_WIDTH, XATTN_WIDTH)
D_IN = sum(IN_SPLITS)
ROPE_THETA = 500000.0
ROPE_DIM = HEAD_DIM // 4
EPS = 1e-6
NEG_INF = -1e30

kernel_name = "hymba_style_rglru_swa_sink_memxattn"


def _rmsnorm(x, g):
    xf = x.astype(jnp.float32)
    y = xf * lax.rsqrt(jnp.mean(xf * xf, axis=-1, keepdims=True) + EPS)
    return (y * g.astype(jnp.float32)).astype(x.dtype)


def _rope_tables(seq):
    pos = jnp.arange(seq, dtype=jnp.float32)
    inv_freq = ROPE_THETA ** (-(jnp.arange(0, ROPE_DIM, 2, dtype=jnp.float32) / ROPE_DIM))
    ang = pos[:, None] * inv_freq[None, :]
    return jnp.cos(ang), jnp.sin(ang)


def _partial_rope(t, cos, sin):
    tf = t.astype(jnp.float32)
    half = ROPE_DIM // 2
    x1, x2, rest = tf[..., :half], tf[..., half:ROPE_DIM], tf[..., ROPE_DIM:]
    c, s = cos[None, :, None, :], sin[None, :, None, :]
    return jnp.concatenate([x1 * c - x2 * s, x2 * c + x1 * s, rest], axis=-1).astype(t.dtype)


def _rg_lru(u, conv_w, conv_b, w_rg, b_rg, w_ig, b_ig, lam):
    B, S, W = u.shape
    xc = lax.conv_general_dilated(
        u, conv_w[:, None, :].astype(u.dtype), window_strides=(1,),
        padding=[(CONV_WIDTH - 1, 0)], dimension_numbers=("NWC", "WIO", "NWC"),
        feature_group_count=W) + conv_b.astype(u.dtype)
    xf = xc.astype(jnp.float32)
    xblk = xf.reshape(B, S, LRU_BLOCKS, LRU_BLOCK)
    r = jax.nn.sigmoid(jnp.einsum("bsnd,nde->bsne", xblk, w_rg.astype(jnp.float32)).reshape(B, S, W)
                       + b_rg.astype(jnp.float32))
    i = jax.nn.sigmoid(jnp.einsum("bsnd,nde->bsne", xblk, w_ig.astype(jnp.float32)).reshape(B, S, W)
                       + b_ig.astype(jnp.float32))
    log_a = -LRU_C * r * jax.nn.softplus(-lam.astype(jnp.float32))
    a = jnp.exp(log_a)
    b = jnp.sqrt(-jnp.expm1(2.0 * log_a)) * (i * xf)

    def combine(c1, c2):
        a1, b1 = c1
        a2, b2 = c2
        return a1 * a2, a2 * b1 + b2

    _, h = lax.associative_scan(combine, (a, b), axis=1)
    return h.astype(u.dtype)


def _band(t):
    B, S, H, D = t.shape
    tb = t.reshape(B, S // BLOCK, BLOCK, H, D)
    prev = jnp.pad(tb, ((0, 0), (1, 0), (0, 0), (0, 0), (0, 0)))[:, :-1]
    return jnp.concatenate([prev, tb], axis=2)


def _swa_sink_attention(q, k, v, sinks):
    B, S, Hq, D = q.shape
    nb = S // BLOCK
    qb = q.reshape(B, nb, BLOCK, SWA_KV_HEADS, SWA_GROUP, D)
    kb, vb = _band(k), _band(v)
    s = jnp.einsum("bnqhgd,bnkhd->bnhgqk", qb, kb,
                   preferred_element_type=jnp.float32) * (1.0 / math.sqrt(D))
    qi = jnp.arange(BLOCK)[:, None]
    kj = jnp.arange(2 * BLOCK)[None, :]
    rel = qi + BLOCK - kj
    band_mask = (rel >= 0) & (rel < WINDOW)
    blk = jnp.arange(nb)[:, None, None]
    mask = band_mask[None] & ((blk > 0) | (kj >= BLOCK)[None])
    s = jnp.where(mask[None, :, None, None], s, NEG_INF)
    sink = sinks.astype(jnp.float32).reshape(SWA_KV_HEADS, SWA_GROUP)[None, None, :, :, None, None]
    m = jnp.maximum(jnp.max(s, axis=-1, keepdims=True), sink)
    p = jnp.exp(s - m)
    denom = jnp.sum(p, axis=-1, keepdims=True) + jnp.exp(sink - m)
    o = jnp.einsum("bnhgqk,bnkhd->bnqhgd", (p / denom).astype(v.dtype), vb)
    return o.reshape(B, S, Hq * D)


def _memory_attention(q, km, vm):
    B, S, H, D = q.shape
    s = jnp.einsum("bshd,bmhd->bhsm", q, km, preferred_element_type=jnp.float32) * (1.0 / math.sqrt(D))
    p = jax.nn.softmax(s, axis=-1)
    o = jnp.einsum("bhsm,bmhd->bshd", p.astype(vm.dtype), vm)
    return o.reshape(B, S, H * D)


def setup_inputs(seed: int = 0) -> dict:
    key = jax.random.key(seed)
    ks = jax.random.split(key, 20)
    f32 = jnp.float32
    nrm = lambda k, shape, scale: jax.random.normal(k, shape, f32) * scale
    x = jax.random.normal(ks[0], (BATCH, SEQ, D_MODEL), f32)
    mem = jax.random.normal(ks[1], (BATCH, MEM_LEN, D_MODEL), f32)
    u = jax.random.uniform(ks[11], (DEPTH, LRU_WIDTH), f32, 0.9, 0.999) ** (1.0 / LRU_C)
    lru_lambda = jnp.log(u) - jnp.log1p(-u)
    return {
        "x": x,
        "mem": mem,
        "norm_g": 1.0 + nrm(ks[2], (DEPTH, D_MODEL), 0.02),
        "mem_norm_g": 1.0 + nrm(ks[3], (DEPTH, D_MODEL), 0.02),
        "w_in": nrm(ks[4], (DEPTH, D_MODEL, D_IN), D_MODEL ** -0.5),
        "conv_w": nrm(ks[5], (DEPTH, CONV_WIDTH, LRU_WIDTH), CONV_WIDTH ** -0.5),
        "conv_b": nrm(ks[6], (DEPTH, LRU_WIDTH), 0.01),
        "w_rg": nrm(ks[7], (DEPTH, LRU_BLOCKS, LRU_BLOCK, LRU_BLOCK), LRU_BLOCK ** -0.5),
        "b_rg": nrm(ks[8], (DEPTH, LRU_WIDTH), 0.01),
        "w_ig": nrm(ks[9], (DEPTH, LRU_BLOCKS, LRU_BLOCK, LRU_BLOCK), LRU_BLOCK ** -0.5),
        "b_ig": nrm(ks[10], (DEPTH, LRU_WIDTH), 0.01),
        "lru_lambda": lru_lambda,
        "q_norm_g": 1.0 + nrm(ks[12], (DEPTH, HEAD_DIM), 0.02),
        "k_norm_g": 1.0 + nrm(ks[13], (DEPTH, HEAD_DIM), 0.02),
        "sinks": nrm(ks[14], (DEPTH, SWA_Q_HEADS), 0.5),
        "w_mem_kv": nrm(ks[15], (DEPTH, D_MODEL, 2 * XATTN_WIDTH), D_MODEL ** -0.5),
        "xq_norm_g": 1.0 + nrm(ks[16], (DEPTH, HEAD_DIM), 0.02),
        "xk_norm_g": 1.0 + nrm(ks[17], (DEPTH, HEAD_DIM), 0.02),
        "out_norm_g": 1.0 + nrm(ks[18], (DEPTH, D_MIX), 0.02),
        "w_out": nrm(ks[19], (DEPTH, D_MIX, D_MODEL), D_MIX ** -0.5),
    }


def reference(x, mem, norm_g, mem_norm_g, w_in, conv_w, conv_b, w_rg, b_rg, w_ig, b_ig, lru_lambda,
              q_norm_g, k_norm_g, sinks, w_mem_kv, xq_norm_g, xk_norm_g, out_norm_g, w_out):
    B, S, _ = x.shape
    M = mem.shape[1]
    cos, sin = _rope_tables(S)
    split_idx = list(np.cumsum(IN_SPLITS)[:-1])
    out_idx = [LRU_WIDTH, LRU_WIDTH + SWA_WIDTH]
    h = x
    for l in range(DEPTH):
        xn = _rmsnorm(h, norm_g[l])
        proj = jnp.einsum("bsd,de->bse", xn, w_in[l])
        (lru_x, lru_gate, sq, sk, sv, swa_gate, xq, x_gate) = jnp.split(proj, split_idx, axis=-1)

        y_a = _rg_lru(lru_x, conv_w[l], conv_b[l], w_rg[l], b_rg[l], w_ig[l], b_ig[l], lru_lambda[l])

        q = _partial_rope(_rmsnorm(sq.reshape(B, S, SWA_Q_HEADS, HEAD_DIM), q_norm_g[l]), cos, sin)
        k = _partial_rope(_rmsnorm(sk.reshape(B, S, SWA_KV_HEADS, HEAD_DIM), k_norm_g[l]), cos, sin)
        v = sv.reshape(B, S, SWA_KV_HEADS, HEAD_DIM)
        y_b = _swa_sink_attention(q, k, v, sinks[l])

        mn = _rmsnorm(mem, mem_norm_g[l])
        mkv = jnp.einsum("bmd,de->bme", mn, w_mem_kv[l])
        km, vm = jnp.split(mkv, 2, axis=-1)
        km = _rmsnorm(km.reshape(B, M, XATTN_HEADS, HEAD_DIM), xk_norm_g[l])
        vm = vm.reshape(B, M, XATTN_HEADS, HEAD_DIM)
        qx = _rmsnorm(xq.reshape(B, S, XATTN_HEADS, HEAD_DIM), xq_norm_g[l])
        y_c = _memory_attention(qx, km, vm)

        g_a, g_b, g_c = jnp.split(out_norm_g[l], out_idx)
        y = jnp.concatenate([
            _rmsnorm(y_a, g_a) * jax.nn.silu(lru_gate),
            _rmsnorm(y_b, g_b) * jax.nn.silu(swa_gate),
            _rmsnorm(y_c, g_c) * jax.nn.silu(x_gate),
        ], axis=-1)
        h = h + jnp.einsum("bse,ed->bsd", y, w_out[l]).astype(h.dtype)
    return h
```

```cpp
#include <hip/hip_runtime.h>
#include <hip/hip_cooperative_groups.h>
#include <cstdio>
#include <cstdint>
namespace cg = cooperative_groups;

namespace pg8 {
#define PG8_LAS __attribute__((address_space(3)))
typedef unsigned short bf16_t;
typedef short bf16x8 __attribute__((ext_vector_type(8)));
typedef float f32x4 __attribute__((ext_vector_type(4)));
typedef unsigned u32x4 __attribute__((ext_vector_type(4)));
constexpr int BM = 256, BK = 64, HALF = 128, HTB = HALF * BK * 2  , STAGE_BYTES = 8 * HTB, NXCD = 8, WGM = 8;

__host__ __device__ __forceinline__ int lds_byte(int r, int c) { const int st = (r >> 4) * 2 + (c >> 5), rr = r & 15, cc = c & 31, ob = rr * 64 + cc * 2; return st * 1024 + (ob ^ (((ob >> 9) & 1) << 5)); }
__host__ __device__ __forceinline__ void stage_rc(int b, int& R, int& C) { const int st = b / 1024, sb = b % 1024, swz = sb ^ (((sb >> 9) & 1) << 5); R = (st >> 1) * 16 + swz / 64; C = (st & 1) * 32 + (swz % 64) / 2; }
__host__ __device__ __forceinline__ int perm32(int rho) { const int n = rho >> 4, i = rho & 15; return 8 * (i >> 2) + 4 * n + (i & 3); }

struct Unit { int pm, pn; };
struct Gemm { const bf16_t* A; const bf16_t* Bt; int M, N, K; };

struct StaticOrder {
    int nM, nN, nwg, G, c, nextra, xpm0, xpn0, xw;
    __host__ __device__ void init(int M, int N, int G_, int c_) { nM = M / BM; nN = N / BM; nwg = nM * nN; G = G_; c = c_; nextra = 0; xpm0 = 0; xpn0 = 0; xw = 1; }
    __host__ __device__ bool next(int i, Unit& u) const {
        const long L = (long)i * G + c; if (L >= nwg + nextra) return false;
        if (L >= nwg) { const int j = (int)L - nwg; u.pm = xpm0 + j / xw; u.pn = xpn0 + j % xw; return true; }
        int wgid = (int)L; { const int q = nwg / NXCD, r = nwg % NXCD, xcd = wgid % NXCD, off = wgid / NXCD; wgid = (xcd < r ? xcd * (q + 1) : r * (q + 1) + (xcd - r) * q) + off; }
        const int nig = WGM * nN, gid = wgid / nig, fm = gid * WGM, gsz = (nM - fm) < WGM ? (nM - fm) : WGM;
        u.pm = fm + ((wgid % nig) % gsz); u.pn = (wgid % nig) / gsz; return true;
    }
    __device__ __forceinline__ void a_ready(const Unit&) const {}
    __device__ __forceinline__ void done(const Unit&) const {}
};
__device__ __forceinline__ unsigned cvt_pk_bf16(float lo, float hi) { unsigned r; asm("v_cvt_pk_bf16_f32 %0, %1, %2" : "=v"(r) : "v"(lo), "v"(hi)); return r; }

template <class Epi, class Sched>
__device__ __forceinline__ void gemm_phase(PG8_LAS unsigned char* lds, const Gemm g, const Sched& S, const Epi& E) {
    const int tid = threadIdx.x, wid = __builtin_amdgcn_readfirstlane(tid >> 6), lane = tid & 63, wr = wid >> 2, wc = wid & 3, fr = lane & 15, fq = lane >> 4;
    const int K = g.K, nt = K / BK;
    unsigned voffA[2], voffB[2];
#pragma unroll
    for (int i = 0; i < 2; ++i) { int R, C; stage_rc(tid * 16 + i * 8192, R, C); const int Rb = Epi::PERM ? ((R & ~31) + perm32(R & 31)) : R;
        voffA[i] = (unsigned)(R * K + C) * 2u; voffB[i] = (unsigned)(Rb * K + C) * 2u; }
    const size_t kstep = (size_t)(BK * 2);
    const size_t hstep = (size_t)HALF * K * 2;
    const size_t tstep = 2 * hstep;
    const unsigned ldsw = (unsigned)wid * 1024u;
    const int aoff = lds_byte(wr * 64 + fr, fq * 8), boff = lds_byte(wc * 32 + fr, fq * 8);
#define PG8_SA(b, h) (((b) * 2 + (h)) * HTB)
#define PG8_SB(b, h) ((4 + (b) * 2 + (h)) * HTB)
#define PG8_STAGE(bufoff, gbase, voff) do { _Pragma("unroll") for (int _i = 0; _i < 2; ++_i) \
        __builtin_amdgcn_global_load_lds((const unsigned*)((const char*)(gbase) + (voff)[_i]), (PG8_LAS unsigned*)(lds + (bufoff) + ldsw + _i * 8192), 16, 0, 0); } while (0)
#define PG8_LDA(dst, b, h) do { _Pragma("unroll") for (int m = 0; m < 4; ++m) _Pragma("unroll") for (int k = 0; k < 2; ++k) dst[m][k] = *(const PG8_LAS bf16x8*)(lds + PG8_SA(b, h) + aoff + m * 2048 + k * 1024); } while (0)
#define PG8_LDB(dst, b, h) do { _Pragma("unroll") for (int n = 0; n < 2; ++n) _Pragma("unroll") for (int k = 0; k < 2; ++k) dst[n][k] = *(const PG8_LAS bf16x8*)(lds + PG8_SB(b, h) + boff + n * 2048 + k * 1024); } while (0)
#define PG8_MMA(ai, bj, At, Bt) do { __builtin_amdgcn_s_setprio(1); _Pragma("unroll") for (int m = 0; m < 4; ++m) _Pragma("unroll") for (int n = 0; n < 2; ++n) _Pragma("unroll") for (int k = 0; k < 2; ++k) \
        acc[ai][bj][m][n] = __builtin_amdgcn_mfma_f32_16x16x32_bf16(Bt[n][k], At[m][k], acc[ai][bj][m][n], 0, 0, 0); __builtin_amdgcn_s_setprio(0); } while (0)
#define PG8_WAIT_V(n) asm volatile("s_waitcnt vmcnt(" #n ")" ::: "memory")
#define PG8_WAIT_L(n) asm volatile("s_waitcnt lgkmcnt(" #n ")" ::: "memory")
#define PG8_BAR __builtin_amdgcn_s_barrier()
#define PG8_SCHED __builtin_amdgcn_sched_barrier(0)
    Unit cur, nxt; int ui = 0;
    if (!S.next(0, cur)) return;
    f32x4 acc[2][2][4][2];
#pragma unroll
    for (int a = 0; a < 2; ++a)
#pragma unroll
        for (int b = 0; b < 2; ++b)
#pragma unroll
            for (int m = 0; m < 4; ++m)
#pragma unroll
                for (int n = 0; n < 2; ++n) acc[a][b][m][n] = (f32x4){0.f, 0.f, 0.f, 0.f};
    bf16x8 At[4][2], B0[2][2], B1[2][2];
    const char* cA = (const char*)g.A + (size_t)cur.pm * tstep; const char* cB = (const char*)g.Bt + (size_t)cur.pn * tstep;
    S.a_ready(cur);
    PG8_STAGE(PG8_SB(0, 0), cB, voffB); PG8_STAGE(PG8_SA(0, 0), cA, voffA); PG8_STAGE(PG8_SB(0, 1), cB + hstep, voffB); PG8_STAGE(PG8_SA(0, 1), cA + hstep, voffA);
    if (wr == 1) PG8_BAR;
    PG8_WAIT_V(4); PG8_BAR;
    PG8_STAGE(PG8_SB(1, 0), cB + kstep, voffB); PG8_STAGE(PG8_SA(1, 0), cA + kstep, voffA); PG8_STAGE(PG8_SB(1, 1), cB + hstep + kstep, voffB);
    PG8_WAIT_V(6); PG8_BAR;
    for (;;) {
        const bool has_next = S.next(ui + 1, nxt);
        const char* nA = has_next ? (const char*)g.A + (size_t)nxt.pm * tstep : cA; const char* nB = has_next ? (const char*)g.Bt + (size_t)nxt.pn * tstep : cB;
        for (int t = 0; t < nt; t += 2) {
            const bool last = (t == nt - 2);
            const char* a1 = cA + (size_t)(t + 1) * kstep;
            const char* a2 = last ? nA : cA + (size_t)(t + 2) * kstep; const char* b2 = last ? nB : cB + (size_t)(t + 2) * kstep;
            const char* a3 = a2 + kstep; const char* b3 = b2 + kstep;
            if (last && has_next) S.a_ready(nxt);
            PG8_LDB(B0, 0, 0); PG8_SCHED; PG8_LDA(At, 0, 0); PG8_STAGE(PG8_SA(1, 1), a1 + hstep, voffA);
            PG8_WAIT_L(8); PG8_BAR; PG8_WAIT_L(0); PG8_MMA(0, 0, At, B0); PG8_BAR; PG8_SCHED;
            PG8_LDB(B1, 0, 1); PG8_STAGE(PG8_SB(0, 0), b2, voffB);
            PG8_BAR; PG8_WAIT_L(0); PG8_MMA(0, 1, At, B1); PG8_BAR;
            PG8_LDA(At, 0, 1); PG8_STAGE(PG8_SA(0, 0), a2, voffA);
            PG8_BAR; PG8_WAIT_L(0); PG8_MMA(1, 0, At, B0); PG8_BAR; PG8_SCHED;
            PG8_STAGE(PG8_SB(0, 1), b2 + hstep, voffB);
            PG8_WAIT_V(6); PG8_BAR; PG8_MMA(1, 1, At, B1); PG8_BAR;
            PG8_LDB(B0, 1, 0); PG8_SCHED; PG8_LDA(At, 1, 0); PG8_STAGE(PG8_SA(0, 1), a2 + hstep, voffA);
            PG8_WAIT_L(8); PG8_BAR; PG8_WAIT_L(0); PG8_MMA(0, 0, At, B0); PG8_BAR; PG8_SCHED;
            PG8_LDB(B1, 1, 1); PG8_STAGE(PG8_SB(1, 0), b3, voffB);
            PG8_BAR; PG8_WAIT_L(0); PG8_MMA(0, 1, At, B1); PG8_BAR;
            PG8_LDA(At, 1, 1); PG8_STAGE(PG8_SA(1, 0), a3, voffA);
            PG8_BAR; PG8_WAIT_L(0); PG8_MMA(1, 0, At, B0); PG8_BAR; PG8_SCHED;
            PG8_STAGE(PG8_SB(1, 1), b3 + hstep, voffB);
            PG8_WAIT_V(6); PG8_BAR; PG8_MMA(1, 1, At, B1); PG8_BAR;
        }
        if constexpr (!Epi::AFTER_DRAIN) { E(acc, cur, wr, wc, fr, fq); S.done(cur); }
        if (!has_next) break;
#pragma unroll
        for (int a = 0; a < 2; ++a)
#pragma unroll
            for (int b = 0; b < 2; ++b)
#pragma unroll
                for (int m = 0; m < 4; ++m)
#pragma unroll
                    for (int n = 0; n < 2; ++n) acc[a][b][m][n] = (f32x4){0.f, 0.f, 0.f, 0.f};
        cur = nxt; cA = nA; cB = nB; ++ui;
    }
    PG8_WAIT_V(0);
    if (wr == 0) PG8_BAR;
    PG8_BAR;
    if constexpr (Epi::AFTER_DRAIN) { E.fused(acc, cur, wr, wc, fr, fq, lds, wid, lane); S.done(cur); }
#undef PG8_SA
#undef PG8_SB
#undef PG8_STAGE
#undef PG8_LDA
#undef PG8_LDB
#undef PG8_MMA
#undef PG8_WAIT_V
#undef PG8_WAIT_L
#undef PG8_BAR
#undef PG8_SCHED
}
}

#ifndef DBG_MODE
#define DBG_MODE 0
#endif
#ifndef DBG_SANITIZE
#define DBG_SANITIZE 0
#endif
#ifndef DBG_NOROPE
#define DBG_NOROPE 0
#endif
typedef unsigned short u16;
typedef pg8::bf16x8 bf16x8;
typedef pg8::f32x4 f32x4;
typedef pg8::u32x4 u32x4;
typedef unsigned u32x2 __attribute__((ext_vector_type(2)));
typedef float f32x2 __attribute__((ext_vector_type(2)));

constexpr int T_TOK = 32768, SEQ = 4096, NBATCH = 8, DM = 1024, DIN = 2304, MEMT = 2048, MEML = 256, DMIX = 1024, LRUW = 512;
constexpr int C_LRUX = 0, C_LRUG = 512, C_SQ = 1024, C_SK = 1280, C_SV = 1408, C_SG = 1536, C_XQ = 1792, C_XG = 2048;
constexpr float EPS = 1e-6f;
constexpr int NTHREADS = 512, LDS_BYTES = 139264;

constexpr size_t WS_A1 = 0;
constexpr size_t WS_BT1 = WS_A1 + (size_t)(T_TOK + MEMT) * DM * 2;
constexpr size_t WS_BT2 = WS_BT1 + (size_t)(DIN + 512) * DM * 2;
constexpr size_t WS_WG = WS_BT2 + (size_t)DM * DMIX * 2;
constexpr size_t WS_ROPE = WS_WG + (size_t)2 * 8 * 64 * 64 * 2;
constexpr size_t WS_PROJ = WS_ROPE + (size_t)SEQ * 16 * 4;
constexpr size_t WS_MKV = WS_PROJ + (size_t)T_TOK * DIN * 2;
constexpr size_t WS_Y = WS_MKV + (size_t)MEMT * 512 * 2;
constexpr size_t WS_HL = WS_Y + (size_t)T_TOK * DMIX * 2;
constexpr size_t WS_PC = WS_HL + (size_t)T_TOK * LRUW * 2;
constexpr size_t WS_AGG = WS_PC + (size_t)T_TOK * LRUW * 2;
constexpr size_t WS_END = WS_AGG + (size_t)NBATCH * 32 * 2 * LRUW * 4;

struct Params {
    const float *x, *mem, *norm_g, *mem_norm_g, *w_in, *conv_w, *conv_b, *w_rg, *b_rg, *w_ig, *b_ig, *lam, *q_norm_g, *k_norm_g, *sinks, *w_mem_kv, *xq_norm_g, *xk_norm_g, *out_norm_g, *w_out;
    float* out; unsigned char* ws;
};

__device__ __forceinline__ unsigned pk2(float lo, float hi) { return pg8::cvt_pk_bf16(lo, hi); }
__device__ __forceinline__ float bflo(unsigned u) { return __uint_as_float(u << 16); }
__device__ __forceinline__ float bfhi(unsigned u) { return __uint_as_float(u & 0xffff0000u); }
__device__ __forceinline__ void unpack8(const u32x4 v, float* f) { f[0] = bflo(v.x); f[1] = bfhi(v.x); f[2] = bflo(v.y); f[3] = bfhi(v.y); f[4] = bflo(v.z); f[5] = bfhi(v.z); f[6] = bflo(v.w); f[7] = bfhi(v.w); }
__device__ __forceinline__ u32x4 pack8(const float* f) { u32x4 r; r.x = pk2(f[0], f[1]); r.y = pk2(f[2], f[3]); r.z = pk2(f[4], f[5]); r.w = pk2(f[6], f[7]); return r; }
__device__ __forceinline__ bf16x8 as_bf16x8(u32x4 v) { union { u32x4 u; bf16x8 b; } c; c.u = v; return c.b; }
__device__ __forceinline__ float wave_sum(float v) {
#pragma unroll
    for (int o = 1; o < 64; o <<= 1) v += __shfl_xor(v, o);
    return v;
}
__device__ __forceinline__ float sigmoid_f(float x) { return __frcp_rn(1.f + __expf(-x)); }
__device__ __forceinline__ float silu_f(float x) { return x * sigmoid_f(x); }

struct EpiProj {
    static constexpr bool PERM = true, AFTER_DRAIN = false;
    u16* proj; u16* mkv;
    __device__ __forceinline__ void operator()(const f32x4 (&acc)[2][2][4][2], const pg8::Unit& u, int wr, int wc, int fr, int fq) const {
        const int row0 = u.pm * 256 + wr * 64 + fr; u16* base; int ld;
        if (u.pn < 9) { ld = DIN; base = proj + (size_t)row0 * DIN + u.pn * 256; }
        else { ld = 512; base = mkv + (size_t)(row0 - T_TOK) * 512 + (u.pn - 9) * 256; }
        base += wc * 32 + 8 * fq;
#pragma unroll
        for (int ai = 0; ai < 2; ++ai)
#pragma unroll
            for (int m = 0; m < 4; ++m) { u16* rowp = base + (size_t)(ai * 128 + m * 16) * ld;
#pragma unroll
                for (int bj = 0; bj < 2; ++bj) { const f32x4 v0 = acc[ai][bj][m][0], v1 = acc[ai][bj][m][1];
                    u32x4 w; w.x = pk2(v0[0], v0[1]); w.y = pk2(v0[2], v0[3]); w.z = pk2(v1[0], v1[1]); w.w = pk2(v1[2], v1[3]);
                    *(u32x4*)(rowp + bj * 128) = w; } }
    }
};
struct EpiOut {
    static constexpr bool PERM = false, AFTER_DRAIN = false;
    float* out; const float* x;
    __device__ __forceinline__ void operator()(const f32x4 (&acc)[2][2][4][2], const pg8::Unit& u, int wr, int wc, int fr, int fq) const {
        const int row0 = u.pm * 256 + wr * 64 + fr, col0 = u.pn * 256 + wc * 32 + 4 * fq;
#pragma unroll
        for (int ai = 0; ai < 2; ++ai)
#pragma unroll
            for (int m = 0; m < 4; ++m) { const size_t off = (size_t)(row0 + ai * 128 + m * 16) * DM + col0;
#pragma unroll
                for (int bj = 0; bj < 2; ++bj)
#pragma unroll
                    for (int n = 0; n < 2; ++n) { const f32x4 r = *(const f32x4*)(x + off + bj * 128 + n * 16); *(f32x4*)(out + off + bj * 128 + n * 16) = acc[ai][bj][m][n] + r; } }
    }
};

__device__ __forceinline__ void p0_transpose_item(const float* W, int K, int N, u16* WT, int row_off, float* scr, int item, int lane) {
    const int nblk = N / 32, kb = item / nblk, nb = item % nblk, k0 = 64 * kb, n0 = 32 * nb;
#pragma unroll 8
    for (int i = 0; i < 32; ++i) { const int kk = 2 * i + (lane >> 5); scr[kk * 33 + (lane & 31)] = W[(size_t)(k0 + kk) * N + n0 + (lane & 31)]; }
    __builtin_amdgcn_s_waitcnt(0xc07f); asm volatile("" ::: "memory");
    const int c = lane & 7;
#pragma unroll
    for (int j = 0; j < 4; ++j) { const int n = (lane >> 3) + 8 * j; const float* s = scr + (8 * c) * 33 + n;
        u32x4 o; o.x = pk2(s[0 * 33], s[1 * 33]); o.y = pk2(s[2 * 33], s[3 * 33]); o.z = pk2(s[4 * 33], s[5 * 33]); o.w = pk2(s[6 * 33], s[7 * 33]);
        *(u32x4*)(WT + (size_t)(row_off + n0 + n) * K + k0 + 8 * c) = o; }
    __builtin_amdgcn_s_waitcnt(0xc07f); asm volatile("" ::: "memory");
}
__device__ __forceinline__ void p0_norm_row(const float* xrow, const float* g, u16* orow, int lane) {
    const f32x4* xr = (const f32x4*)xrow + lane; const f32x4* gr = (const f32x4*)g + lane;
    f32x4 v[4]; float s = 0.f;
#pragma unroll
    for (int j = 0; j < 4; ++j) { v[j] = xr[64 * j]; s += (v[j].x * v[j].x + v[j].y * v[j].y) + (v[j].z * v[j].z + v[j].w * v[j].w); }
    const float rs = rsqrtf(wave_sum(s) * (1.f / DM) + EPS);
    u32x2* o8 = (u32x2*)orow + lane;
#pragma unroll
    for (int j = 0; j < 4; ++j) { const f32x4 gg = gr[64 * j]; u32x2 o; o.x = pk2(v[j].x * rs * gg.x, v[j].y * rs * gg.y); o.y = pk2(v[j].z * rs * gg.z, v[j].w * rs * gg.w); o8[64 * j] = o; }
}
__device__ __forceinline__ void phase0(const Params& p, unsigned char* lds) {
    const int tid = threadIdx.x, lane = tid & 63, wave = tid >> 6;
    const int gw = blockIdx.x * 8 + wave, NGW = gridDim.x * 8;
    float* scr = (float*)(lds + wave * 16384);
    u16* A1 = (u16*)(p.ws + WS_A1); u16* Bt1 = (u16*)(p.ws + WS_BT1); u16* Bt2 = (u16*)(p.ws + WS_BT2); u16* Wg = (u16*)(p.ws + WS_WG); float* rope = (float*)(p.ws + WS_ROPE);
    constexpr int I_IN = 16 * (DIN / 32), I_MKV = 16 * (512 / 32), I_OUT = 16 * (DM / 32);
    for (int it = gw; it < I_IN + I_MKV + I_OUT; it += NGW) {
        if (it < I_IN) p0_transpose_item(p.w_in, DM, DIN, Bt1, 0, scr, it, lane);
        else if (it < I_IN + I_MKV) p0_transpose_item(p.w_mem_kv, DM, 512, Bt1, DIN, scr, it - I_IN, lane);
        else p0_transpose_item(p.w_out, DMIX, DM, Bt2, 0, scr, it - I_IN - I_MKV, lane);
    }
    for (int m = gw; m < T_TOK + MEMT; m += NGW) {
        if (m < T_TOK) p0_norm_row(p.x + (size_t)m * DM, p.norm_g, A1 + (size_t)m * DM, lane);
        else p0_norm_row(p.mem + (size_t)(m - T_TOK) * DM, p.mem_norm_g, A1 + (size_t)m * DM, lane);
    }
    const int gt = blockIdx.x * NTHREADS + tid, NGT = gridDim.x * NTHREADS;
    for (int i = gt; i < 2 * 8 * 64 * 64; i += NGT) {
        const int d = i & 63, e = (i >> 6) & 63, n = (i >> 12) & 7, g = i >> 15;
        const float v = (g ? p.w_ig : p.w_rg)[(n * 64 + d) * 64 + e];
        Wg[i] = (u16)(pk2(v, 0.f) & 0xffffu);
    }
    for (int i = gt; i < SEQ * 8; i += NGT) {
        const int pos = i >> 3, j = i & 7;
        const float inv_freq = (float)exp(-(double)j * 0.125 * 13.122363377404328);
        const float ang = (float)pos * inv_freq;
        const double rev = (double)ang * 0.15915494309189535; const double fr = rev - floor(rev);
        const double t4 = fr * 4.0; const double qd = floor(t4 + 0.5); const int quad = ((int)qd) & 3;
        const double xx = (t4 - qd) * 1.5707963267948966, x2 = xx * xx;
        const double sn = xx * (1.0 - x2 / 6.0 * (1.0 - x2 / 20.0 * (1.0 - x2 / 42.0 * (1.0 - x2 / 72.0 * (1.0 - x2 / 110.0 * (1.0 - x2 / 156.0))))));
        const double cs = 1.0 - x2 / 2.0 * (1.0 - x2 / 12.0 * (1.0 - x2 / 30.0 * (1.0 - x2 / 56.0 * (1.0 - x2 / 90.0 * (1.0 - x2 / 132.0)))));
        double co, si;
        if (quad == 0) { co = cs; si = sn; } else if (quad == 1) { co = -sn; si = cs; } else if (quad == 2) { co = -cs; si = -sn; } else { co = sn; si = -cs; }
        rope[pos * 16 + j] = (float)co; rope[pos * 16 + 8 + j] = (float)si;
    }
}

__device__ __forceinline__ void phase1(const Params& p, unsigned char* lds) {
    pg8::Gemm g{(const u16*)(p.ws + WS_A1), (const u16*)(p.ws + WS_BT1), T_TOK + MEMT, DIN + 512, DM};
    pg8::StaticOrder S; S.init(T_TOK, DIN, (int)gridDim.x, (int)blockIdx.x); S.nextra = 16; S.xpm0 = 128; S.xpn0 = 9; S.xw = 2;
    EpiProj E{(u16*)(p.ws + WS_PROJ), (u16*)(p.ws + WS_MKV)};
    pg8::gemm_phase<EpiProj, pg8::StaticOrder>((PG8_LAS unsigned char*)lds, g, S, E);
}
__device__ __forceinline__ void phase4(const Params& p, unsigned char* lds) {
    pg8::Gemm g{(const u16*)(p.ws + WS_Y), (const u16*)(p.ws + WS_BT2), T_TOK, DM, DMIX};
    pg8::StaticOrder S; S.init(T_TOK, DM, (int)gridDim.x, (int)blockIdx.x);
    EpiOut E{p.out, p.x};
    pg8::gemm_phase<EpiOut, pg8::StaticOrder>((PG8_LAS unsigned char*)lds, g, S, E);
}

constexpr int KL_PITCH = 72;
constexpr int VT_PITCH = 264;
constexpr int KL_BYTES = 256 * KL_PITCH * 2;
constexpr int VT_BYTES = 64 * VT_PITCH * 2;
constexpr int OB_PITCH = 264;

__device__ __forceinline__ void p2_lru(const Params& p, unsigned char* lds, int b, int nb) {
    const int tid = threadIdx.x, lane = tid & 63, n = tid >> 6, q = lane >> 4, tl = lane & 15;
    const u16* proj = (const u16*)(p.ws + WS_PROJ); const u16* Wg = (const u16*)(p.ws + WS_WG);
    u16* HL = (u16*)(p.ws + WS_HL); u16* PC = (u16*)(p.ws + WS_PC); float* AGG = (float*)(p.ws + WS_AGG);
    const int tok0 = b * SEQ + nb * 128;
    float* ctab = (float*)lds;
    {
        const int c = tid; const float l = -p.lam[c];
        const float sp = fmaxf(l, 0.f) + log1pf(__expf(-fabsf(l)));
        f32x4 a = {p.conv_w[c], p.conv_w[512 + c], p.conv_w[1024 + c], p.conv_w[1536 + c]};
        f32x4 b2 = {p.conv_b[c], p.b_rg[c], p.b_ig[c], -8.f * sp};
        *(f32x4*)(ctab + c * 8) = a; *(f32x4*)(ctab + c * 8 + 4) = b2;
    }
    __syncthreads();
    const int chA = n * 64 + q * 8, chB = chA + 32;
    float carryH[16], carryP[16];
#pragma unroll
    for (int i = 0; i < 16; ++i) { carryH[i] = 0.f; carryP[i] = 1.f; }
#pragma unroll 1
    for (int mb = 0; mb < 8; ++mb) {
        asm volatile("" ::: "memory");
        const int t = mb * 16 + tl;
        float xc[16];
#pragma unroll
        for (int i = 0; i < 16; ++i) xc[i] = ctab[((i < 8 ? chA : chB - 8) + i) * 8 + 4];
#pragma unroll
        for (int tap = 0; tap < 4; ++tap) {
            const int tt = t - 3 + tap; const bool valid = (nb > 0) || (tt >= 0);
            u32x4 ua = {0u, 0u, 0u, 0u}, ub = {0u, 0u, 0u, 0u};
            if (valid) { const u16* src = proj + (size_t)(tok0 + tt) * DIN + C_LRUX; ua = *(const u32x4*)(src + chA); ub = *(const u32x4*)(src + chB); }
            float fa[8], fb[8]; unpack8(ua, fa); unpack8(ub, fb);
#pragma unroll
            for (int i = 0; i < 8; ++i) { xc[i] += ctab[(chA + i) * 8 + tap] * fa[i]; xc[8 + i] += ctab[(chB + i) * 8 + tap] * fb[i]; }
        }
        bf16x8 bfr[2]; bfr[0] = as_bf16x8(pack8(xc)); bfr[1] = as_bf16x8(pack8(xc + 8));
        float hv[16], pv[16];
#pragma unroll
        for (int cb = 0; cb < 4; ++cb) {
            f32x4 aR = {0.f, 0.f, 0.f, 0.f}, aI = {0.f, 0.f, 0.f, 0.f};
            const int e = (cb >> 1) * 32 + (tl >> 2) * 8 + (cb & 1) * 4 + (tl & 3);
#pragma unroll
            for (int ks = 0; ks < 2; ++ks) {
                const bf16x8 wr_ = *(const bf16x8*)(Wg + ((0 * 8 + n) * 64 + e) * 64 + ks * 32 + q * 8);
                const bf16x8 wi_ = *(const bf16x8*)(Wg + ((1 * 8 + n) * 64 + e) * 64 + ks * 32 + q * 8);
                aR = __builtin_amdgcn_mfma_f32_16x16x32_bf16(wr_, bfr[ks], aR, 0, 0, 0);
                aI = __builtin_amdgcn_mfma_f32_16x16x32_bf16(wi_, bfr[ks], aI, 0, 0, 0);
            }
#pragma unroll
            for (int j = 0; j < 4; ++j) {
                const int i16 = cb * 4 + j; const int ch = (i16 < 8 ? chA : chB - 8) + i16;
                const float r = sigmoid_f(aR[j] + ctab[ch * 8 + 5]), ig = sigmoid_f(aI[j] + ctab[ch * 8 + 6]);
                const float la = ctab[ch * 8 + 7] * r;
                float a = __expf(la); float bb = sqrtf(-expm1f(2.f * la)) * (ig * xc[i16]);
#pragma unroll
                for (int d = 1; d < 16; d <<= 1) {
                    float ap = __shfl_up(a, d, 16), bp = __shfl_up(bb, d, 16);
                    if (tl < d) { ap = 1.f; bp = 0.f; }
                    bb = a * bp + bb; a = a * ap;
                }
                const float h = bb + a * carryH[i16], pc = a * carryP[i16];
                hv[i16] = h; pv[i16] = pc;
                carryH[i16] = __shfl(h, 15, 16); carryP[i16] = __shfl(pc, 15, 16);
            }
        }
        const size_t ro = (size_t)(tok0 + t) * LRUW;
        *(u32x4*)(HL + ro + chA) = pack8(hv); *(u32x4*)(HL + ro + chB) = pack8(hv + 8);
        *(u32x4*)(PC + ro + chA) = pack8(pv); *(u32x4*)(PC + ro + chB) = pack8(pv + 8);
    }
    if (tl == 15) {
        float* ag = AGG + (size_t)(b * 32 + nb) * 2 * LRUW;
#pragma unroll
        for (int i = 0; i < 16; ++i) { const int ch = (i < 8 ? chA : chB - 8) + i; ag[ch] = carryP[i]; ag[LRUW + ch] = carryH[i]; }
    }
}

template <bool SWA>
__device__ __forceinline__ void p2_attn(const Params& p, unsigned char* lds, int b, int nb) {
    constexpr int NKV = SWA ? 2 : 4, GQ = SWA ? 2 : 1, NKB = SWA ? 10 : 16;
    constexpr int QCOL = SWA ? C_SQ : C_XQ, GCOL = SWA ? C_SG : C_XG, YOFF = SWA ? 512 : 768;
    const int tid = threadIdx.x, lane = tid & 63, w = tid >> 6, q = lane >> 4, tl = lane & 15;
    const u16* proj = (const u16*)(p.ws + WS_PROJ); const u16* mkv = (const u16*)(p.ws + WS_MKV); const float* rope = (const float*)(p.ws + WS_ROPE);
    u16* Y = (u16*)(p.ws + WS_Y);
    const int tok0 = b * SEQ + nb * 128; const int qrow = tok0 + 16 * w + tl;
    u16* Kl = (u16*)lds; u16* Vt = (u16*)(lds + KL_BYTES); u16* Ob = (u16*)(lds + KL_BYTES + VT_BYTES) + w * (16 * OB_PITCH) + tl * OB_PITCH + q * 4;
    const float* gq = SWA ? p.q_norm_g : p.xq_norm_g; const float* gk = SWA ? p.k_norm_g : p.xk_norm_g;
    const int kb0 = SWA ? (w < 6 ? w : 6) : 0;
    float ssq = 0.f;
#pragma unroll 1
    for (int kvh = 0; kvh < NKV; ++kvh) {
        __syncthreads();
#pragma unroll 1
        for (int pass = 0; pass < 2; ++pass) {
            const int key = pass * 128 + (tid >> 2), kq = tid & 3; bool valid = true; const u16 *ksrc, *vsrc;
            if (SWA) { valid = (nb > 0) || (key >= 128); const u16* rowp = proj + ((long)tok0 + key - 128) * DIN; ksrc = rowp + C_SK + kvh * 64 + kq * 16; vsrc = rowp + C_SV + kvh * 64 + kq * 16; }
            else { const u16* rowp = mkv + (size_t)(b * MEML + key) * 512; ksrc = rowp + kvh * 64 + kq * 16; vsrc = rowp + 256 + kvh * 64 + kq * 16; }
            u32x4 kr[2], vr[2];
#pragma unroll
            for (int i = 0; i < 2; ++i) { kr[i] = (u32x4){0u, 0u, 0u, 0u}; vr[i] = kr[i]; }
            if (valid) {
#pragma unroll
                for (int i = 0; i < 2; ++i) { kr[i] = ((const u32x4*)ksrc)[i]; vr[i] = ((const u32x4*)vsrc)[i]; } }
            float xk[16];
            unpack8(kr[0], xk); unpack8(kr[1], xk + 8);
            float ss = 0.f;
#pragma unroll
            for (int i = 0; i < 16; ++i) ss += xk[i] * xk[i];
            ss += __shfl_xor(ss, 1); ss += __shfl_xor(ss, 2);
            const float rs = rsqrtf(ss * (1.f / 64.f) + EPS);
#pragma unroll
            for (int i = 0; i < 16; ++i) xk[i] = xk[i] * rs * gk[kq * 16 + i];
            if (SWA && kq == 0 && !(DBG_NOROPE & 1)) {
                int pos = nb * 128 + key - 128; pos = pos < 0 ? 0 : pos;
                const float* rt = rope + pos * 16;
#pragma unroll
                for (int i = 0; i < 8; ++i) { const float c = rt[i], s = rt[8 + i], x1 = xk[i], x2 = xk[8 + i]; xk[i] = x1 * c - x2 * s; xk[8 + i] = x2 * c + x1 * s; }
            }
            u32x4* kdst = (u32x4*)(Kl + key * KL_PITCH + kq * 16);
            kdst[0] = pack8(xk); kdst[1] = pack8(xk + 8);
            u16* vdst = Vt + (kq * 16) * VT_PITCH + key;
#pragma unroll
            for (int i = 0; i < 2; ++i) {
                const unsigned wv[4] = {vr[i].x, vr[i].y, vr[i].z, vr[i].w};
#pragma unroll
                for (int k2 = 0; k2 < 4; ++k2) { vdst[(8 * i + 2 * k2) * VT_PITCH] = (u16)(wv[k2] & 0xffffu); vdst[(8 * i + 2 * k2 + 1) * VT_PITCH] = (u16)(wv[k2] >> 16); }
            }
        }
        __syncthreads();
#pragma unroll 1
        for (int g = 0; g < GQ; ++g) {
            const int hh = SWA ? kvh * 2 + g : kvh;
            bf16x8 qf[2];
            {
                const u16* qsrc = proj + (size_t)qrow * DIN + QCOL + hh * 64 + q * 8;
                const u32x4 r0 = *(const u32x4*)qsrc, r1 = *(const u32x4*)(qsrc + 32);
                float x0[8], x1[8]; unpack8(r0, x0); unpack8(r1, x1);
                float ss = 0.f;
#pragma unroll
                for (int i = 0; i < 8; ++i) ss += x0[i] * x0[i] + x1[i] * x1[i];
                ss += __shfl_xor(ss, 16); ss += __shfl_xor(ss, 32);
                const float rs = rsqrtf(ss * (1.f / 64.f) + EPS) * 0.125f;
#pragma unroll
                for (int i = 0; i < 8; ++i) { x0[i] = x0[i] * rs * gq[q * 8 + i]; x1[i] = x1[i] * rs * gq[32 + q * 8 + i]; }
                if (SWA && !(DBG_NOROPE & 2)) {
                    const float* rt = rope + (nb * 128 + 16 * w + tl) * 16;
                    const u32x4 rp = *(const u32x4*)(proj + (size_t)qrow * DIN + QCOL + hh * 64 + ((q ^ 1) & 1) * 8);
                    float xp[8]; unpack8(rp, xp);
                    const float sg = (q == 0) ? -1.f : ((q == 1) ? 1.f : 0.f);
#pragma unroll
                    for (int i = 0; i < 8; ++i) {
                        const float c = (q < 2) ? rt[i] : 1.f, s = sg * rt[8 + i];
                        x0[i] = x0[i] * c + (xp[i] * rs * gq[((q ^ 1) & 1) * 8 + i]) * s;
                    }
                }
                qf[0] = as_bf16x8(pack8(x0)); qf[1] = as_bf16x8(pack8(x1));
            }
            f32x4 sacc[NKB];
#pragma unroll
            for (int kbi = 0; kbi < NKB; ++kbi) {
                sacc[kbi] = (f32x4){0.f, 0.f, 0.f, 0.f};
                const u16* kp = Kl + ((kb0 + kbi) * 16 + tl) * KL_PITCH + q * 8;
#pragma unroll
                for (int ks = 0; ks < 2; ++ks) { const bf16x8 kf = *(const bf16x8*)(kp + ks * 32); sacc[kbi] = __builtin_amdgcn_mfma_f32_16x16x32_bf16(kf, qf[ks], sacc[kbi], 0, 0, 0); }
            }
            const float sink = SWA ? p.sinks[hh] : -1e30f;
            float mx = sink;
            const int qi = 16 * w + tl;
#pragma unroll
            for (int kbi = 0; kbi < NKB; ++kbi)
#pragma unroll
                for (int j = 0; j < 4; ++j) {
                    if (SWA) { const int kj = (kb0 + kbi) * 16 + q * 4 + j; const bool ok = (kj > qi) && (kj <= qi + 128) && ((nb > 0) || (kj >= 128)); if (!ok) sacc[kbi][j] = -1e30f; }
                    mx = fmaxf(mx, sacc[kbi][j]);
                }
            mx = fmaxf(mx, __shfl_xor(mx, 16)); mx = fmaxf(mx, __shfl_xor(mx, 32));
            float sum = 0.f;
#pragma unroll
            for (int kbi = 0; kbi < NKB; ++kbi)
#pragma unroll
                for (int j = 0; j < 4; ++j) { const float pe = __expf(sacc[kbi][j] - mx); sacc[kbi][j] = pe; sum += pe; }
            sum += __shfl_xor(sum, 16); sum += __shfl_xor(sum, 32);
            if (SWA) sum += __expf(sink - mx);
            const float inv = 1.f / sum;
            f32x4 oacc[4];
#pragma unroll
            for (int db = 0; db < 4; ++db) oacc[db] = (f32x4){0.f, 0.f, 0.f, 0.f};
#pragma unroll
            for (int kp2 = 0; kp2 < NKB / 2; ++kp2) {
                u32x4 pw; pw.x = pk2(sacc[2 * kp2][0], sacc[2 * kp2][1]); pw.y = pk2(sacc[2 * kp2][2], sacc[2 * kp2][3]); pw.z = pk2(sacc[2 * kp2 + 1][0], sacc[2 * kp2 + 1][1]); pw.w = pk2(sacc[2 * kp2 + 1][2], sacc[2 * kp2 + 1][3]);
                const bf16x8 pf = as_bf16x8(pw);
#pragma unroll
                for (int db = 0; db < 4; ++db) {
                    const u16* vp = Vt + (db * 16 + tl) * VT_PITCH + (kb0 + 2 * kp2) * 16 + q * 4;
                    const u32x2 v0 = *(const u32x2*)vp, v1 = *(const u32x2*)(vp + 16);
                    u32x4 vw; vw.x = v0.x; vw.y = v0.y; vw.z = v1.x; vw.w = v1.y;
                    oacc[db] = __builtin_amdgcn_mfma_f32_16x16x32_bf16(as_bf16x8(vw), pf, oacc[db], 0, 0, 0);
                }
            }
#pragma unroll
            for (int db = 0; db < 4; ++db) {
                const f32x4 o = oacc[db] * inv;
                ssq += (o[0] * o[0] + o[1] * o[1]) + (o[2] * o[2] + o[3] * o[3]);
                u32x2 ow; ow.x = pk2(o[0], o[1]); ow.y = pk2(o[2], o[3]);
                *(u32x2*)(Ob + hh * 64 + db * 16) = ow;
            }
        }
    }
    ssq += __shfl_xor(ssq, 16); ssq += __shfl_xor(ssq, 32);
    const float rs = rsqrtf(ssq * (1.f / 256.f) + EPS);
#pragma unroll 4
    for (int i = 0; i < 16; ++i) {
        const int c = i * 16 + q * 4;
        const u32x2 ov = *(const u32x2*)(Ob + i * 16);
        const u32x2 gt = *(const u32x2*)(proj + (size_t)qrow * DIN + GCOL + c);
        const f32x4 gn = *(const f32x4*)(p.out_norm_g + YOFF + c);
        u32x2 yo; yo.x = pk2(bflo(ov.x) * rs * gn[0] * silu_f(bflo(gt.x)), bfhi(ov.x) * rs * gn[1] * silu_f(bfhi(gt.x))); yo.y = pk2(bflo(ov.y) * rs * gn[2] * silu_f(bflo(gt.y)), bfhi(ov.y) * rs * gn[3] * silu_f(bfhi(gt.y)));
        *(u32x2*)(Y + (size_t)qrow * DMIX + YOFF + c) = yo;
    }
}
__device__ __forceinline__ void phase2(const Params& p, unsigned char* lds) {
    for (int tile = blockIdx.x; tile < NBATCH * 32; tile += gridDim.x) {
        const int b = tile >> 5, nb = tile & 31;
        __syncthreads();
        p2_lru(p, lds, b, nb);
        p2_attn<true>(p, lds, b, nb);
        p2_attn<false>(p, lds, b, nb);
    }
}

__device__ __forceinline__ void phase3(const Params& p) {
    const int tid = threadIdx.x, lane = tid & 63, w = tid >> 6;
    const u16* proj = (const u16*)(p.ws + WS_PROJ); const u16* HL = (const u16*)(p.ws + WS_HL); const u16* PC = (const u16*)(p.ws + WS_PC); const float* AGG = (const float*)(p.ws + WS_AGG);
    u16* Y = (u16*)(p.ws + WS_Y);
    const int c0 = lane * 8;
    float gn[8];
#pragma unroll
    for (int i = 0; i < 8; ++i) gn[i] = p.out_norm_g[c0 + i];
    for (int tile = blockIdx.x; tile < NBATCH * 32; tile += gridDim.x) {
        const int b = tile >> 5, nb = tile & 31, tok0 = b * SEQ + nb * 128;
        float carry[8];
#pragma unroll
        for (int i = 0; i < 8; ++i) carry[i] = 0.f;
        for (int j = 0; j < nb; ++j) {
            const float* ag = AGG + (size_t)(b * 32 + j) * 2 * LRUW + c0;
            const f32x4 p0 = *(const f32x4*)ag, p1 = *(const f32x4*)(ag + 4), h0 = *(const f32x4*)(ag + LRUW), h1 = *(const f32x4*)(ag + LRUW + 4);
#pragma unroll
            for (int i = 0; i < 4; ++i) { carry[i] = carry[i] * p0[i] + h0[i]; carry[4 + i] = carry[4 + i] * p1[i] + h1[i]; }
        }
        for (int tt = 0; tt < 16; ++tt) {
            const size_t row = (size_t)tok0 + w * 16 + tt;
            const u32x4 hl = *(const u32x4*)(HL + row * LRUW + c0), pc = *(const u32x4*)(PC + row * LRUW + c0), gt = *(const u32x4*)(proj + row * DIN + C_LRUG + c0);
            float h[8], pf[8], gf[8]; unpack8(hl, h); unpack8(pc, pf); unpack8(gt, gf);
            float ss = 0.f;
#pragma unroll
            for (int i = 0; i < 8; ++i) { h[i] = h[i] + pf[i] * carry[i]; ss += h[i] * h[i]; }
            const float rs = rsqrtf(wave_sum(ss) * (1.f / LRUW) + EPS);
            float yv[8];
#pragma unroll
            for (int i = 0; i < 8; ++i) yv[i] = h[i] * rs * gn[i] * silu_f(gf[i]);
            *(u32x4*)(Y + row * DMIX + c0) = pack8(yv);
        }
    }
}

template <int PH> __global__ void __launch_bounds__(NTHREADS, 2) k_phase(Params p) {
    extern __shared__ __attribute__((aligned(16))) unsigned char lds[];
    if (PH == 0) phase0(p, lds);
    if (PH == 1) phase1(p, lds);
    if (PH == 2) phase2(p, lds);
    if (PH == 3) phase3(p);
    if (PH == 4) phase4(p, lds);
}
__global__ void __launch_bounds__(NTHREADS, 2) k_mega(Params p) {
    extern __shared__ __attribute__((aligned(16))) unsigned char lds[];
    cg::grid_group grid = cg::this_grid();
    phase0(p, lds); grid.sync();
    phase1(p, lds); grid.sync();
    phase2(p, lds); grid.sync();
    phase3(p); grid.sync();
    phase4(p, lds);
}


__global__ void __launch_bounds__(NTHREADS) k_dump(Params p, int mode) {
    const u16* proj = (const u16*)(p.ws + WS_PROJ); const u16* mkv = (const u16*)(p.ws + WS_MKV); const u16* Y = (const u16*)(p.ws + WS_Y);
    const u16* HL = (const u16*)(p.ws + WS_HL); const u16* PC = (const u16*)(p.ws + WS_PC); const float* AGG = (const float*)(p.ws + WS_AGG);
    for (size_t i = (size_t)blockIdx.x * NTHREADS + threadIdx.x; i < (size_t)T_TOK * DM; i += (size_t)gridDim.x * NTHREADS) {
        const size_t r = i >> 10; const int c = (int)(i & 1023);
        float v = 0.f;
        if (mode == 1) { v = bflo(proj[r * DIN + c]) + bflo(proj[r * DIN + 1024 + c]) + (c < 256 ? bflo(proj[r * DIN + 2048 + c]) : 0.f) + bflo(mkv[(r & 2047) * 512 + (c & 511)]); }
        if (mode == 2) { v = (c < 512 ? bflo(HL[r * 512 + c]) + bflo(PC[r * 512 + c]) : 0.f) + AGG[i & (NBATCH * 32 * 2 * LRUW - 1)]; }
        if (mode == 3) { v = (c >= 512 && c < 768) ? bflo(Y[r * 1024 + c]) : 0.f; }
        if (mode == 4) { v = (c >= 768) ? bflo(Y[r * 1024 + c]) : 0.f; }
        if (mode == 5) { v = bflo(Y[r * 1024 + c]); }
        if (mode == 6) { v = ((const float*)(p.ws + WS_ROPE))[i & 65535]; }
        if (DBG_SANITIZE && !(fabsf(v) < 1e30f)) v = 12345.f;
        p.out[i] = v;
    }
}
#ifndef N_LAUNCH_MODE
#define N_LAUNCH_MODE 5
#endif
extern "C" void kernel_launch(void* const* d_in, const int* in_sizes, int n_in, void* d_out, int out_size, void* d_ws, size_t ws_size, hipStream_t stream) {
    static int grid = 0;
    if (grid == 0) {
        if (n_in != 20 || out_size != T_TOK * DM || ws_size < WS_END) { fprintf(stderr, "kernel_launch: unexpected shapes (n_in %d out %d ws %zu)\n", n_in, out_size, ws_size); grid = -1; return; }
        int dev = 0, cus = 0, per_cu = 0;
        hipGetDevice(&dev); hipDeviceGetAttribute(&cus, hipDeviceAttributeMultiprocessorCount, dev);
        hipFuncSetAttribute((const void*)k_phase<0>, hipFuncAttributeMaxDynamicSharedMemorySize, LDS_BYTES);
        hipFuncSetAttribute((const void*)k_phase<1>, hipFuncAttributeMaxDynamicSharedMemorySize, LDS_BYTES);
        hipFuncSetAttribute((const void*)k_phase<2>, hipFuncAttributeMaxDynamicSharedMemorySize, LDS_BYTES);
        hipFuncSetAttribute((const void*)k_phase<3>, hipFuncAttributeMaxDynamicSharedMemorySize, LDS_BYTES);
        hipFuncSetAttribute((const void*)k_phase<4>, hipFuncAttributeMaxDynamicSharedMemorySize, LDS_BYTES);
        hipFuncSetAttribute((const void*)k_mega, hipFuncAttributeMaxDynamicSharedMemorySize, LDS_BYTES);
        hipOccupancyMaxActiveBlocksPerMultiprocessor(&per_cu, (const void*)k_mega, NTHREADS, LDS_BYTES);
        if (per_cu < 1) { fprintf(stderr, "kernel_launch: occupancy query says %d blocks per CU\n", per_cu); per_cu = 1; }
        if (per_cu > 1) per_cu = 1;
        grid = cus * per_cu;
        (void)hipGetLastError();
    }
    if (grid < 0) return;
    Params p{};
    p.x = (const float*)d_in[0]; p.mem = (const float*)d_in[1]; p.norm_g = (const float*)d_in[2]; p.mem_norm_g = (const float*)d_in[3]; p.w_in = (const float*)d_in[4];
    p.conv_w = (const float*)d_in[5]; p.conv_b = (const float*)d_in[6]; p.w_rg = (const float*)d_in[7]; p.b_rg = (const float*)d_in[8]; p.w_ig = (const float*)d_in[9]; p.b_ig = (const float*)d_in[10];
    p.lam = (const float*)d_in[11]; p.q_norm_g = (const float*)d_in[12]; p.k_norm_g = (const float*)d_in[13]; p.sinks = (const float*)d_in[14]; p.w_mem_kv = (const float*)d_in[15];
    p.xq_norm_g = (const float*)d_in[16]; p.xk_norm_g = (const float*)d_in[17]; p.out_norm_g = (const float*)d_in[18]; p.w_out = (const float*)d_in[19];
    p.out = (float*)d_out; p.ws = (unsigned char*)d_ws;
#if N_LAUNCH_MODE == 1
    void* args[] = {&p};
    hipError_t e = hipLaunchCooperativeKernel((const void*)k_mega, dim3(grid), dim3(NTHREADS), args, LDS_BYTES, stream);
    if (e != hipSuccess) fprintf(stderr, "cooperative launch failed: %s (grid %d)\n", hipGetErrorString(e), grid);
#else
    hipLaunchKernelGGL(k_phase<0>, dim3(grid), dim3(NTHREADS), LDS_BYTES, stream, p);
    hipLaunchKernelGGL(k_phase<1>, dim3(grid), dim3(NTHREADS), LDS_BYTES, stream, p);
#if DBG_MODE == 1 || DBG_MODE == 6
    hipLaunchKernelGGL(k_dump, dim3(1024), dim3(NTHREADS), 0, stream, p, DBG_MODE);
#elif DBG_MODE >= 2 && DBG_MODE <= 4
    hipLaunchKernelGGL(k_phase<2>, dim3(grid), dim3(NTHREADS), LDS_BYTES, stream, p);
    hipLaunchKernelGGL(k_dump, dim3(1024), dim3(NTHREADS), 0, stream, p, DBG_MODE);
#elif DBG_MODE == 5
    hipLaunchKernelGGL(k_phase<2>, dim3(grid), dim3(NTHREADS), LDS_BYTES, stream, p);
    hipLaunchKernelGGL(k_phase<3>, dim3(grid), dim3(NTHREADS), LDS_BYTES, stream, p);
    hipLaunchKernelGGL(k_dump, dim3(1024), dim3(NTHREADS), 0, stream, p, 5);
#else
    hipLaunchKernelGGL(k_phase<2>, dim3(grid), dim3(NTHREADS), LDS_BYTES, stream, p);
    hipLaunchKernelGGL(k_phase<3>, dim3(grid), dim3(NTHREADS), LDS_BYTES, stream, p);
    hipLaunchKernelGGL(k_phase<4>, dim3(grid), dim3(NTHREADS), LDS_BYTES, stream, p);
#endif
#endif
}
```

```cpp
#include <hip/hip_runtime.h>
#include <cstdio>
#include <cstdint>

namespace pg8 {
#define PG8_LAS __attribute__((address_space(3)))
typedef unsigned short bf16_t;
typedef short bf16x8 __attribute__((ext_vector_type(8)));
typedef float f32x4 __attribute__((ext_vector_type(4)));
typedef unsigned u32x4 __attribute__((ext_vector_type(4)));
constexpr int BM = 256, BK = 64, HALF = 128, HTB = HALF * BK * 2  , STAGE_BYTES = 8 * HTB, NXCD = 8, WGM = 8;

__host__ __device__ __forceinline__ int lds_byte(int r, int c) { const int st = (r >> 4) * 2 + (c >> 5), rr = r & 15, cc = c & 31, ob = rr * 64 + cc * 2; return st * 1024 + (ob ^ (((ob >> 9) & 1) << 5)); }
__host__ __device__ __forceinline__ void stage_rc(int b, int& R, int& C) { const int st = b / 1024, sb = b % 1024, swz = sb ^ (((sb >> 9) & 1) << 5); R = (st >> 1) * 16 + swz / 64; C = (st & 1) * 32 + (swz % 64) / 2; }
__host__ __device__ __forceinline__ int perm32(int rho) { const int n = rho >> 4, i = rho & 15; return 8 * (i >> 2) + 4 * n + (i & 3); }

struct Unit { int pm, pn; };
struct Gemm { const bf16_t* A; const bf16_t* Bt; int M, N, K; };

struct StaticOrder {
    int nM, nN, nwg, G, c, nextra, xpm0, xpn0, xw;
    __host__ __device__ void init(int M, int N, int G_, int c_) { nM = M / BM; nN = N / BM; nwg = nM * nN; G = G_; c = c_; nextra = 0; xpm0 = 0; xpn0 = 0; xw = 1; }
    __host__ __device__ bool next(int i, Unit& u) const {
        const long L = (long)i * G + c; if (L >= nwg + nextra) return false;
        if (L >= nwg) { const int j = (int)L - nwg; u.pm = xpm0 + j / xw; u.pn = xpn0 + j % xw; return true; }
        int wgid = (int)L; { const int q = nwg / NXCD, r = nwg % NXCD, xcd = wgid % NXCD, off = wgid / NXCD; wgid = (xcd < r ? xcd * (q + 1) : r * (q + 1) + (xcd - r) * q) + off; }
        const int nig = WGM * nN, gid = wgid / nig, fm = gid * WGM, gsz = (nM - fm) < WGM ? (nM - fm) : WGM;
        u.pm = fm + ((wgid % nig) % gsz); u.pn = (wgid % nig) / gsz; return true;
    }
    __device__ __forceinline__ void a_ready(const Unit&) const {}
    __device__ __forceinline__ void done(const Unit&) const {}
};
__device__ __forceinline__ unsigned cvt_pk_bf16(float lo, float hi) { unsigned r; asm("v_cvt_pk_bf16_f32 %0, %1, %2" : "=v"(r) : "v"(lo), "v"(hi)); return r; }

template <class Epi, class Sched>
__device__ __forceinline__ void gemm_phase(PG8_LAS unsigned char* lds, const Gemm g, const Sched& S, const Epi& E) {
    int tid = threadIdx.x; asm volatile("" : "+v"(tid));
    const int wid = __builtin_amdgcn_readfirstlane(tid >> 6), lane = tid & 63, wr = wid >> 2, wc = wid & 3, fr = lane & 15, fq = lane >> 4;
    const int K = g.K, nt = K / BK;
    unsigned voffA[2], voffB[2];
#pragma unroll
    for (int i = 0; i < 2; ++i) { int R, C; stage_rc(tid * 16 + i * 8192, R, C); const int Rb = Epi::PERM ? ((R & ~31) + perm32(R & 31)) : R;
        voffA[i] = (unsigned)(R * K + C) * 2u; voffB[i] = (unsigned)(Rb * K + C) * 2u; }
    const size_t kstep = (size_t)(BK * 2);
    const size_t hstep = (size_t)HALF * K * 2;
    const size_t tstep = 2 * hstep;
    const unsigned ldsw = (unsigned)wid * 1024u;
    const int aoff = lds_byte(wr * 64 + fr, fq * 8), boff = lds_byte(wc * 32 + fr, fq * 8);
#define PG8_SA(b, h) (((b) * 2 + (h)) * HTB)
#define PG8_SB(b, h) ((4 + (b) * 2 + (h)) * HTB)
#define PG8_STAGE(bufoff, gbase, voff) do { _Pragma("unroll") for (int _i = 0; _i < 2; ++_i) \
        __builtin_amdgcn_global_load_lds((const unsigned*)((const char*)(gbase) + (voff)[_i]), (PG8_LAS unsigned*)(lds + (bufoff) + ldsw + _i * 8192), 16, 0, 0); } while (0)
#define PG8_LDA(dst, b, h) do { _Pragma("unroll") for (int m = 0; m < 4; ++m) _Pragma("unroll") for (int k = 0; k < 2; ++k) dst[m][k] = *(const PG8_LAS bf16x8*)(lds + PG8_SA(b, h) + aoff + m * 2048 + k * 1024); } while (0)
#define PG8_LDB(dst, b, h) do { _Pragma("unroll") for (int n = 0; n < 2; ++n) _Pragma("unroll") for (int k = 0; k < 2; ++k) dst[n][k] = *(const PG8_LAS bf16x8*)(lds + PG8_SB(b, h) + boff + n * 2048 + k * 1024); } while (0)
#define PG8_MMA(ai, bj, At, Bt) do { __builtin_amdgcn_s_setprio(1); _Pragma("unroll") for (int m = 0; m < 4; ++m) _Pragma("unroll") for (int n = 0; n < 2; ++n) _Pragma("unroll") for (int k = 0; k < 2; ++k) \
        acc[ai][bj][m][n] = __builtin_amdgcn_mfma_f32_16x16x32_bf16(Bt[n][k], At[m][k], acc[ai][bj][m][n], 0, 0, 0); __builtin_amdgcn_s_setprio(0); } while (0)
#define PG8_WAIT_V(n) asm volatile("s_waitcnt vmcnt(" #n ")" ::: "memory")
#define PG8_WAIT_L(n) asm volatile("s_waitcnt lgkmcnt(" #n ")" ::: "memory")
#define PG8_BAR __builtin_amdgcn_s_barrier()
#define PG8_SCHED __builtin_amdgcn_sched_barrier(0)
    Unit cur, nxt; int ui = 0;
    if (!S.next(0, cur)) return;
    f32x4 acc[2][2][4][2];
#pragma unroll
    for (int a = 0; a < 2; ++a)
#pragma unroll
        for (int b = 0; b < 2; ++b)
#pragma unroll
            for (int m = 0; m < 4; ++m)
#pragma unroll
                for (int n = 0; n < 2; ++n) acc[a][b][m][n] = (f32x4){0.f, 0.f, 0.f, 0.f};
    bf16x8 At[4][2], B0[2][2], B1[2][2];
    const char* cA = (const char*)g.A + (size_t)cur.pm * tstep; const char* cB = (const char*)g.Bt + (size_t)cur.pn * tstep;
    S.a_ready(cur);
    PG8_STAGE(PG8_SB(0, 0), cB, voffB); PG8_STAGE(PG8_SA(0, 0), cA, voffA); PG8_STAGE(PG8_SB(0, 1), cB + hstep, voffB); PG8_STAGE(PG8_SA(0, 1), cA + hstep, voffA);
    if (wr == 1) PG8_BAR;
    PG8_WAIT_V(4); PG8_BAR;
    PG8_STAGE(PG8_SB(1, 0), cB + kstep, voffB); PG8_STAGE(PG8_SA(1, 0), cA + kstep, voffA); PG8_STAGE(PG8_SB(1, 1), cB + hstep + kstep, voffB);
    PG8_WAIT_V(6); PG8_BAR;
    for (;;) {
        const bool has_next = S.next(ui + 1, nxt);
        const char* nA = has_next ? (const char*)g.A + (size_t)nxt.pm * tstep : cA; const char* nB = has_next ? (const char*)g.Bt + (size_t)nxt.pn * tstep : cB;
        for (int t = 0; t < nt; t += 2) {
            const bool last = (t == nt - 2);
            const char* a1 = cA + (size_t)(t + 1) * kstep;
            const char* a2 = last ? nA : cA + (size_t)(t + 2) * kstep; const char* b2 = last ? nB : cB + (size_t)(t + 2) * kstep;
            const char* a3 = a2 + kstep; const char* b3 = b2 + kstep;
            if (last && has_next) S.a_ready(nxt);
            PG8_LDB(B0, 0, 0); PG8_SCHED; PG8_LDA(At, 0, 0); PG8_STAGE(PG8_SA(1, 1), a1 + hstep, voffA);
            PG8_WAIT_L(8); PG8_BAR; PG8_WAIT_L(0); PG8_MMA(0, 0, At, B0); PG8_BAR; PG8_SCHED;
            PG8_LDB(B1, 0, 1); PG8_STAGE(PG8_SB(0, 0), b2, voffB);
            PG8_BAR; PG8_WAIT_L(0); PG8_MMA(0, 1, At, B1); PG8_BAR;
            PG8_LDA(At, 0, 1); PG8_STAGE(PG8_SA(0, 0), a2, voffA);
            PG8_BAR; PG8_WAIT_L(0); PG8_MMA(1, 0, At, B0); PG8_BAR; PG8_SCHED;
            PG8_STAGE(PG8_SB(0, 1), b2 + hstep, voffB);
            PG8_WAIT_V(6); PG8_BAR; PG8_MMA(1, 1, At, B1); PG8_BAR;
            PG8_LDB(B0, 1, 0); PG8_SCHED; PG8_LDA(At, 1, 0); PG8_STAGE(PG8_SA(0, 1), a2 + hstep, voffA);
            PG8_WAIT_L(8); PG8_BAR; PG8_WAIT_L(0); PG8_MMA(0, 0, At, B0); PG8_BAR; PG8_SCHED;
            PG8_LDB(B1, 1, 1); PG8_STAGE(PG8_SB(1, 0), b3, voffB);
            PG8_BAR; PG8_WAIT_L(0); PG8_MMA(0, 1, At, B1); PG8_BAR;
            PG8_LDA(At, 1, 1); PG8_STAGE(PG8_SA(1, 0), a3, voffA);
            PG8_BAR; PG8_WAIT_L(0); PG8_MMA(1, 0, At, B0); PG8_BAR; PG8_SCHED;
            PG8_STAGE(PG8_SB(1, 1), b3 + hstep, voffB);
            PG8_WAIT_V(6); PG8_BAR; PG8_MMA(1, 1, At, B1); PG8_BAR;
        }
        if constexpr (!Epi::AFTER_DRAIN) { E(acc, cur, wr, wc, fr, fq); S.done(cur); }
        if (!has_next) break;
#pragma unroll
        for (int a = 0; a < 2; ++a)
#pragma unroll
            for (int b = 0; b < 2; ++b)
#pragma unroll
                for (int m = 0; m < 4; ++m)
#pragma unroll
                    for (int n = 0; n < 2; ++n) acc[a][b][m][n] = (f32x4){0.f, 0.f, 0.f, 0.f};
        cur = nxt; cA = nA; cB = nB; ++ui;
    }
    PG8_WAIT_V(0);
    if (wr == 0) PG8_BAR;
    PG8_BAR;
    if constexpr (Epi::AFTER_DRAIN) { E.fused(acc, cur, wr, wc, fr, fq, lds, wid, lane); S.done(cur); }
#undef PG8_SA
#undef PG8_SB
#undef PG8_STAGE
#undef PG8_LDA
#undef PG8_LDB
#undef PG8_MMA
#undef PG8_WAIT_V
#undef PG8_WAIT_L
#undef PG8_BAR
#undef PG8_SCHED
}
}

typedef unsigned short u16;
typedef pg8::bf16x8 bf16x8;
typedef pg8::f32x4 f32x4;
typedef pg8::u32x4 u32x4;
typedef unsigned u32x2 __attribute__((ext_vector_type(2)));
typedef float f32x2 __attribute__((ext_vector_type(2)));

constexpr int T_TOK = 32768, SEQ = 4096, NBATCH = 8, DM = 1024, DIN = 2304, MEMT = 2048, MEML = 256, DMIX = 1024, LRUW = 512;
constexpr int C_LRUX = 0, C_LRUG = 512, C_SQ = 1024, C_SK = 1280, C_SV = 1408, C_SG = 1536, C_XQ = 1792, C_XG = 2048;
constexpr float EPS = 1e-6f;
constexpr int NTHREADS = 512, LDS_BYTES = 147520;

constexpr size_t WS_A1 = 0;
constexpr size_t WS_BT1 = WS_A1 + (size_t)(T_TOK + MEMT) * DM * 2;
constexpr size_t WS_BT2 = WS_BT1 + (size_t)(DIN + 512) * DM * 2;
constexpr size_t WS_WG = WS_BT2 + (size_t)DM * DMIX * 2;
constexpr size_t WS_ROPE = WS_WG + (size_t)2 * 8 * 64 * 64 * 2;
constexpr size_t WS_PROJ = WS_ROPE + (size_t)SEQ * 16 * 4;
constexpr size_t WS_MKV = WS_PROJ + (size_t)T_TOK * DIN * 2;
constexpr size_t WS_Y = WS_MKV + (size_t)MEMT * 512 * 2;
constexpr size_t WS_HL = WS_Y + (size_t)T_TOK * DMIX * 2;
constexpr size_t WS_PC = WS_HL + (size_t)T_TOK * LRUW * 2;
constexpr size_t WS_AGG = WS_PC + (size_t)T_TOK * LRUW * 2;
constexpr size_t WS_BAR = WS_AGG + (size_t)NBATCH * 32 * 2 * LRUW * 4;
constexpr size_t WS_END = WS_BAR + 16384;

struct Params {
    const float *x, *mem, *norm_g, *mem_norm_g, *w_in, *conv_w, *conv_b, *w_rg, *b_rg, *w_ig, *b_ig, *lam, *q_norm_g, *k_norm_g, *sinks, *w_mem_kv, *xq_norm_g, *xk_norm_g, *out_norm_g, *w_out;
    float* out; unsigned char* ws;
};

__device__ __forceinline__ int fresh_tid() { int t = threadIdx.x; asm volatile("" : "+v"(t)); return t; }
__device__ __forceinline__ unsigned pk2(float lo, float hi) { return pg8::cvt_pk_bf16(lo, hi); }
__device__ __forceinline__ float bflo(unsigned u) { return __uint_as_float(u << 16); }
__device__ __forceinline__ float bfhi(unsigned u) { return __uint_as_float(u & 0xffff0000u); }
__device__ __forceinline__ void unpack8(const u32x4 v, float* f) { f[0] = bflo(v.x); f[1] = bfhi(v.x); f[2] = bflo(v.y); f[3] = bfhi(v.y); f[4] = bflo(v.z); f[5] = bfhi(v.z); f[6] = bflo(v.w); f[7] = bfhi(v.w); }
__device__ __forceinline__ u32x4 pack8(const float* f) { u32x4 r; r.x = pk2(f[0], f[1]); r.y = pk2(f[2], f[3]); r.z = pk2(f[4], f[5]); r.w = pk2(f[6], f[7]); return r; }
__device__ __forceinline__ bf16x8 as_bf16x8(u32x4 v) { union { u32x4 u; bf16x8 b; } c; c.u = v; return c.b; }
__device__ __forceinline__ float wave_sum(float v) {
#pragma unroll
    for (int o = 1; o < 64; o <<= 1) v += __shfl_xor(v, o);
    return v;
}
__device__ __forceinline__ float sigmoid_f(float x) { return __builtin_amdgcn_rcpf(1.f + __expf(-x)); }
__device__ __forceinline__ float silu_f(float x) { return x * sigmoid_f(x); }

struct EpiProj {
    static constexpr bool PERM = true, AFTER_DRAIN = false;
    u16* proj; u16* mkv;
    __device__ __forceinline__ void operator()(const f32x4 (&acc)[2][2][4][2], const pg8::Unit& u, int wr, int wc, int fr, int fq) const {
        const int row0 = u.pm * 256 + wr * 64 + fr; u16* base; int ld;
        if (u.pn < 9) { ld = DIN; base = proj + (size_t)row0 * DIN + u.pn * 256; }
        else { ld = 512; base = mkv + (size_t)(row0 - T_TOK) * 512 + (u.pn - 9) * 256; }
        base += wc * 32 + 8 * fq;
#pragma unroll
        for (int ai = 0; ai < 2; ++ai)
#pragma unroll
            for (int m = 0; m < 4; ++m) { u16* rowp = base + (size_t)(ai * 128 + m * 16) * ld;
#pragma unroll
                for (int bj = 0; bj < 2; ++bj) { const f32x4 v0 = acc[ai][bj][m][0], v1 = acc[ai][bj][m][1];
                    u32x4 w; w.x = pk2(v0[0], v0[1]); w.y = pk2(v0[2], v0[3]); w.z = pk2(v1[0], v1[1]); w.w = pk2(v1[2], v1[3]);
                    *(u32x4*)(rowp + bj * 128) = w; } }
    }
};
struct EpiOut {
    static constexpr bool PERM = false, AFTER_DRAIN = false;
    float* out; const float* x;
    __device__ __forceinline__ void operator()(const f32x4 (&acc)[2][2][4][2], const pg8::Unit& u, int wr, int wc, int fr, int fq) const {
        const int row0 = u.pm * 256 + wr * 64 + fr, col0 = u.pn * 256 + wc * 32 + 4 * fq;
#pragma unroll
        for (int ai = 0; ai < 2; ++ai) {
            f32x4 r[4][2][2];
#pragma unroll
            for (int m = 0; m < 4; ++m) { const size_t off = (size_t)(row0 + ai * 128 + m * 16) * DM + col0;
#pragma unroll
                for (int bj = 0; bj < 2; ++bj)
#pragma unroll
                    for (int n = 0; n < 2; ++n) r[m][bj][n] = *(const f32x4*)(x + off + bj * 128 + n * 16); }
            asm volatile("" ::: "memory");
#pragma unroll
            for (int m = 0; m < 4; ++m) { const size_t off = (size_t)(row0 + ai * 128 + m * 16) * DM + col0;
#pragma unroll
                for (int bj = 0; bj < 2; ++bj)
#pragma unroll
                    for (int n = 0; n < 2; ++n) *(f32x4*)(out + off + bj * 128 + n * 16) = acc[ai][bj][m][n] + r[m][bj][n]; }
        }
    }
};

__device__ __forceinline__ void p0_transpose_item(const float* W, int K, int N, u16* WT, int row_off, float* scr, int item, int lane) {
    const int nblk = N / 32, kb = item / nblk, nb = item % nblk, k0 = 64 * kb, n0 = 32 * nb;
#pragma unroll 8
    for (int i = 0; i < 32; ++i) { const int kk = 2 * i + (lane >> 5); scr[kk * 33 + (lane & 31)] = __builtin_nontemporal_load(W + (size_t)(k0 + kk) * N + n0 + (lane & 31)); }
    __builtin_amdgcn_s_waitcnt(0xc07f); asm volatile("" ::: "memory");
    const int c = lane & 7;
#pragma unroll
    for (int j = 0; j < 4; ++j) { const int n = (lane >> 3) + 8 * j; const float* s = scr + (8 * c) * 33 + n;
        u32x4 o; o.x = pk2(s[0 * 33], s[1 * 33]); o.y = pk2(s[2 * 33], s[3 * 33]); o.z = pk2(s[4 * 33], s[5 * 33]); o.w = pk2(s[6 * 33], s[7 * 33]);
        *(u32x4*)(WT + (size_t)(row_off + n0 + n) * K + k0 + 8 * c) = o; }
    __builtin_amdgcn_s_waitcnt(0xc07f); asm volatile("" ::: "memory");
}
template <int NR>
__device__ __forceinline__ void p0_norm_rows(const float* const (&xrow)[NR], const float* g, u16* const (&orow)[NR], int lane) {
    f32x4 v[NR][4]; float s[NR];
#pragma unroll
    for (int r = 0; r < NR; ++r) { const f32x4* xr = (const f32x4*)xrow[r] + lane;
#pragma unroll
        for (int j = 0; j < 4; ++j) v[r][j] = __builtin_nontemporal_load(xr + 64 * j); }
    const f32x4* gr = (const f32x4*)g + lane; f32x4 gg[4];
#pragma unroll
    for (int j = 0; j < 4; ++j) gg[j] = gr[64 * j];
#pragma unroll
    for (int r = 0; r < NR; ++r) { s[r] = 0.f;
#pragma unroll
        for (int j = 0; j < 4; ++j) s[r] += (v[r][j].x * v[r][j].x + v[r][j].y * v[r][j].y) + (v[r][j].z * v[r][j].z + v[r][j].w * v[r][j].w); }
#pragma unroll
    for (int o = 1; o < 64; o <<= 1) {
#pragma unroll
        for (int r = 0; r < NR; ++r) s[r] += __shfl_xor(s[r], o); }
#pragma unroll
    for (int r = 0; r < NR; ++r) { const float rs = rsqrtf(s[r] * (1.f / DM) + EPS); u32x2* o8 = (u32x2*)orow[r] + lane;
#pragma unroll
        for (int j = 0; j < 4; ++j) { u32x2 o; o.x = pk2(v[r][j].x * rs * gg[j].x, v[r][j].y * rs * gg[j].y); o.y = pk2(v[r][j].z * rs * gg[j].z, v[r][j].w * rs * gg[j].w); o8[64 * j] = o; } }
}
__device__ __forceinline__ void phase0(const Params& p, unsigned char* lds) {
    const int tid = fresh_tid(), lane = tid & 63, wave = tid >> 6;
    const int gw = blockIdx.x * 8 + wave, NGW = gridDim.x * 8;
    float* scr = (float*)(lds + wave * 16384);
    u16* A1 = (u16*)(p.ws + WS_A1); u16* Bt1 = (u16*)(p.ws + WS_BT1); u16* Bt2 = (u16*)(p.ws + WS_BT2); u16* Wg = (u16*)(p.ws + WS_WG); float* rope = (float*)(p.ws + WS_ROPE);
    constexpr int I_IN = 16 * (DIN / 32), I_MKV = 16 * (512 / 32), I_OUT = 16 * (DM / 32);
    for (int it = gw; it < I_IN + I_MKV + I_OUT; it += NGW) {
        if (it < I_IN) p0_transpose_item(p.w_in, DM, DIN, Bt1, 0, scr, it, lane);
        else if (it < I_IN + I_MKV) p0_transpose_item(p.w_mem_kv, DM, 512, Bt1, DIN, scr, it - I_IN, lane);
        else p0_transpose_item(p.w_out, DMIX, DM, Bt2, 0, scr, it - I_IN - I_MKV, lane);
    }
    for (int m = gw; m < T_TOK; m += 4 * NGW) {
        const int m1 = min(m + NGW, T_TOK - 1), m2 = min(m + 2 * NGW, T_TOK - 1), m3 = min(m + 3 * NGW, T_TOK - 1);
        const float* const xr[4] = {p.x + (size_t)m * DM, p.x + (size_t)m1 * DM, p.x + (size_t)m2 * DM, p.x + (size_t)m3 * DM};
        u16* const orr[4] = {A1 + (size_t)m * DM, A1 + (size_t)m1 * DM, A1 + (size_t)m2 * DM, A1 + (size_t)m3 * DM};
        p0_norm_rows<4>(xr, p.norm_g, orr, lane);
    }
    for (int m = gw; m < MEMT; m += NGW) {
        const float* const xr[1] = {p.mem + (size_t)m * DM}; u16* const orr[1] = {A1 + (size_t)(T_TOK + m) * DM};
        p0_norm_rows<1>(xr, p.mem_norm_g, orr, lane);
    }
    const int gt = blockIdx.x * NTHREADS + tid, NGT = gridDim.x * NTHREADS;
    for (int i = gt; i < 2 * 8 * 64 * 64; i += NGT) {
        const int d = i & 63, e = (i >> 6) & 63, n = (i >> 12) & 7, g = i >> 15;
        const float v = (g ? p.w_ig : p.w_rg)[(n * 64 + d) * 64 + e];
        Wg[i] = (u16)(pk2(v, 0.f) & 0xffffu);
    }
    for (int i = gt; i < SEQ * 8; i += NGT) {
        const int pos = i >> 3, j = i & 7;
        const float inv_freq = (float)exp(-(double)j * 0.125 * 13.122363377404328);
        const float ang = (float)pos * inv_freq;
        const double rev = (double)ang * 0.15915494309189535; const double fr = rev - floor(rev);
        const double t4 = fr * 4.0; const double qd = floor(t4 + 0.5); const int quad = ((int)qd) & 3;
        const double xx = (t4 - qd) * 1.5707963267948966, x2 = xx * xx;
        const double sn = xx * (1.0 - x2 / 6.0 * (1.0 - x2 / 20.0 * (1.0 - x2 / 42.0 * (1.0 - x2 / 72.0 * (1.0 - x2 / 110.0 * (1.0 - x2 / 156.0))))));
        const double cs = 1.0 - x2 / 2.0 * (1.0 - x2 / 12.0 * (1.0 - x2 / 30.0 * (1.0 - x2 / 56.0 * (1.0 - x2 / 90.0 * (1.0 - x2 / 132.0)))));
        double co, si;
        if (quad == 0) { co = cs; si = sn; } else if (quad == 1) { co = -sn; si = cs; } else if (quad == 2) { co = -cs; si = -sn; } else { co = sn; si = -cs; }
        rope[pos * 16 + j] = (float)co; rope[pos * 16 + 8 + j] = (float)si;
    }
}

__device__ __forceinline__ void phase1(const Params& p, unsigned char* lds) {
    pg8::Gemm g{(const u16*)(p.ws + WS_A1), (const u16*)(p.ws + WS_BT1), T_TOK + MEMT, DIN + 512, DM};
    pg8::StaticOrder S; S.init(T_TOK, DIN, (int)gridDim.x, (int)blockIdx.x); S.nextra = 16; S.xpm0 = 128; S.xpn0 = 9; S.xw = 2;
    EpiProj E{(u16*)(p.ws + WS_PROJ), (u16*)(p.ws + WS_MKV)};
    pg8::gemm_phase<EpiProj, pg8::StaticOrder>((PG8_LAS unsigned char*)lds, g, S, E);
}
__device__ __forceinline__ void phase4(const Params& p, unsigned char* lds) {
    pg8::Gemm g{(const u16*)(p.ws + WS_Y), (const u16*)(p.ws + WS_BT2), T_TOK, DM, DMIX};
    pg8::StaticOrder S; S.init(T_TOK, DM, (int)gridDim.x, (int)blockIdx.x);
    EpiOut E{p.out, p.x};
    pg8::gemm_phase<EpiOut, pg8::StaticOrder>((PG8_LAS unsigned char*)lds, g, S, E);
}

constexpr int KL_PITCH = 72;
constexpr int VT_PITCH = 264;
constexpr int KL_BYTES = 256 * KL_PITCH * 2;
constexpr int VT_BYTES = 64 * VT_PITCH * 2;
constexpr int OB_PITCH = 264;

template <int CTRL> __device__ __forceinline__ float dpp_mov(float oldv, float srcv) {
    return __int_as_float(__builtin_amdgcn_update_dpp(__float_as_int(oldv), __float_as_int(srcv), CTRL, 0xf, 0xf, false));
}
__device__ __forceinline__ void p2_lru(const Params& p, unsigned char* lds, int b, int nb) {
    const int tid = fresh_tid(), lane = tid & 63, n = tid >> 6, q = lane >> 4, tl = lane & 15;
    const u16* proj = (const u16*)(p.ws + WS_PROJ); const u16* Wg = (const u16*)(p.ws + WS_WG);
    u16* HL = (u16*)(p.ws + WS_HL); u16* PC = (u16*)(p.ws + WS_PC); float* AGG = (float*)(p.ws + WS_AGG);
    const int tok0 = b * SEQ + nb * 128;
    float* ctab = (float*)lds;
    {
        const int c = tid; const float l = -p.lam[c];
        const float sp = fmaxf(l, 0.f) + log1pf(__expf(-fabsf(l)));
        f32x4 a = {p.conv_w[c], p.conv_w[512 + c], p.conv_w[1024 + c], p.conv_w[1536 + c]};
        f32x4 b2 = {p.conv_b[c], p.b_rg[c], p.b_ig[c], -8.f * sp};
        *(f32x4*)(ctab + c * 8) = a; *(f32x4*)(ctab + c * 8 + 4) = b2;
    }
    const int chA = n * 64 + q * 8, chB = chA + 32;
    u32x4 ua[4], ub[4];
    auto load_u = [&](int mb) {
#pragma unroll
        for (int tap = 0; tap < 4; ++tap) {
            const int tt = mb * 16 + tl - 3 + tap; const bool valid = (nb > 0) || (tt >= 0);
            ua[tap] = (u32x4){0u, 0u, 0u, 0u}; ub[tap] = ua[tap];
            if (valid) { const u16* src = proj + (size_t)(tok0 + tt) * DIN + C_LRUX; ua[tap] = *(const u32x4*)(src + chA); ub[tap] = *(const u32x4*)(src + chB); }
        }
    };
    load_u(0);
    unsigned char* wl = lds + 16384 + n * 16384;
    {
        const u32x4* wsrc0 = (const u32x4*)(Wg + (size_t)(0 * 8 + n) * 4096); const u32x4* wsrc1 = (const u32x4*)(Wg + (size_t)(1 * 8 + n) * 4096);
#pragma unroll
        for (int k = 0; k < 8; ++k) {
            const int i = k * 64 + lane, e = i >> 3, c = i & 7, sw = (((e >> 3) & 3) << 1) | ((e >> 1) & 1);
            const u32x4 v0 = wsrc0[i], v1 = wsrc1[i];
            *(u32x4*)(wl + e * 128 + ((c ^ sw) << 4)) = v0; *(u32x4*)(wl + 8192 + e * 128 + ((c ^ sw) << 4)) = v1;
        }
    }
    __syncthreads();
    float hprev[16], pprev[16], cbr[16], cbi[16], cnl[16];
#pragma unroll
    for (int i = 0; i < 16; ++i) { hprev[i] = 0.f; pprev[i] = 1.f; const int ch = (i < 8 ? chA : chB - 8) + i; cbr[i] = -1.4426950408889634f * ctab[ch * 8 + 5]; cbi[i] = -1.4426950408889634f * ctab[ch * 8 + 6]; cnl[i] = 1.4426950408889634f * ctab[ch * 8 + 7]; }
#pragma unroll 1
    for (int mb = 0; mb < 8; ++mb) {
        asm volatile("" ::: "memory");
        const int t = mb * 16 + tl;
        float xc[16];
#pragma unroll
        for (int i = 0; i < 16; ++i) xc[i] = ctab[((i < 8 ? chA : chB - 8) + i) * 8 + 4];
#pragma unroll
        for (int tap = 0; tap < 4; ++tap) {
            float fa[8], fb[8]; unpack8(ua[tap], fa); unpack8(ub[tap], fb);
#pragma unroll
            for (int i = 0; i < 8; ++i) { xc[i] += ctab[(chA + i) * 8 + tap] * fa[i]; xc[8 + i] += ctab[(chB + i) * 8 + tap] * fb[i]; }
        }
        bf16x8 bfr[2]; bfr[0] = as_bf16x8(pack8(xc)); bfr[1] = as_bf16x8(pack8(xc + 8));
        f32x4 aR[4], aI[4];
#pragma unroll
        for (int cb = 0; cb < 4; ++cb) {
            const int e = (cb >> 1) * 32 + (tl >> 2) * 8 + (cb & 1) * 4 + (tl & 3), sw = (((e >> 3) & 3) << 1) | ((e >> 1) & 1);
            aR[cb] = (f32x4){0.f, 0.f, 0.f, 0.f}; aI[cb] = aR[cb];
#pragma unroll
            for (int ks = 0; ks < 2; ++ks) {
                const bf16x8 wr_ = *(const bf16x8*)(wl + e * 128 + (((ks * 4 + q) ^ sw) << 4));
                const bf16x8 wi_ = *(const bf16x8*)(wl + 8192 + e * 128 + (((ks * 4 + q) ^ sw) << 4));
                aR[cb] = __builtin_amdgcn_mfma_f32_16x16x32_bf16(wr_, bfr[ks], aR[cb], 0, 0, 0);
                aI[cb] = __builtin_amdgcn_mfma_f32_16x16x32_bf16(wi_, bfr[ks], aI[cb], 0, 0, 0);
            }
        }
        asm volatile("" ::: "memory");
        if (mb < 7) load_u(mb + 1);
#pragma unroll
        for (int cb = 0; cb < 4; ++cb) {
            float av[4], bv[4];
#pragma unroll
            for (int j2 = 0; j2 < 4; j2 += 2) {
                const int i16 = cb * 4 + j2;
                const f32x2 tr = (f32x2){aR[cb][j2], aR[cb][j2 + 1]} * -1.4426950408889634f + (f32x2){cbr[i16], cbr[i16 + 1]};
                const f32x2 ti = (f32x2){aI[cb][j2], aI[cb][j2 + 1]} * -1.4426950408889634f + (f32x2){cbi[i16], cbi[i16 + 1]};
                const f32x2 dr = (f32x2){__builtin_amdgcn_exp2f(tr.x), __builtin_amdgcn_exp2f(tr.y)} + 1.f, di = (f32x2){__builtin_amdgcn_exp2f(ti.x), __builtin_amdgcn_exp2f(ti.y)} + 1.f;
                const f32x2 r = {__builtin_amdgcn_rcpf(dr.x), __builtin_amdgcn_rcpf(dr.y)}, ig = {__builtin_amdgcn_rcpf(di.x), __builtin_amdgcn_rcpf(di.y)};
                const f32x2 la2 = (f32x2){cnl[i16], cnl[i16 + 1]} * r;
                const f32x2 a = {__builtin_amdgcn_exp2f(la2.x), __builtin_amdgcn_exp2f(la2.y)};
                const f32x2 x2 = la2 * 1.3862943611198906f;
                f32x2 ps = x2 * 0.0083333338f + 0.041666668f; ps = ps * x2 + 0.16666667f; ps = ps * x2 + 0.5f; ps = ps * x2 + 1.f;
                const f32x2 om_s = -(x2 * ps), om_l = 1.f - a * a;
                const float om0 = (x2.x > -0.25f) ? om_s.x : om_l.x, om1 = (x2.y > -0.25f) ? om_s.y : om_l.y;
                const f32x2 b2 = (f32x2){__builtin_amdgcn_sqrtf(om0), __builtin_amdgcn_sqrtf(om1)} * (ig * (f32x2){xc[i16], xc[i16 + 1]});
                av[j2] = a.x; av[j2 + 1] = a.y; bv[j2] = b2.x; bv[j2 + 1] = b2.y;
            }
#define LRU_STEP(sh) \
            "v_fmac_f32_dpp %0, %0, %1 " sh " row_mask:0xf bank_mask:0xf\n v_fmac_f32_dpp %2, %2, %3 " sh " row_mask:0xf bank_mask:0xf\n" \
            "v_fmac_f32_dpp %4, %4, %5 " sh " row_mask:0xf bank_mask:0xf\n v_fmac_f32_dpp %6, %6, %7 " sh " row_mask:0xf bank_mask:0xf\n" \
            "v_mul_f32_dpp %1, %1, %1 " sh " row_mask:0xf bank_mask:0xf\n v_mul_f32_dpp %3, %3, %3 " sh " row_mask:0xf bank_mask:0xf\n" \
            "v_mul_f32_dpp %5, %5, %5 " sh " row_mask:0xf bank_mask:0xf\n v_mul_f32_dpp %7, %7, %7 " sh " row_mask:0xf bank_mask:0xf\n"
            asm volatile("s_nop 1\n"
                "v_fmac_f32_dpp %0, %8, %1 row_shl:15 row_mask:0xf bank_mask:0xf\n v_fmac_f32_dpp %2, %10, %3 row_shl:15 row_mask:0xf bank_mask:0xf\n"
                "v_fmac_f32_dpp %4, %12, %5 row_shl:15 row_mask:0xf bank_mask:0xf\n v_fmac_f32_dpp %6, %14, %7 row_shl:15 row_mask:0xf bank_mask:0xf\n"
                "v_mul_f32_dpp %1, %9, %1 row_shl:15 row_mask:0xf bank_mask:0xf\n v_mul_f32_dpp %3, %11, %3 row_shl:15 row_mask:0xf bank_mask:0xf\n"
                "v_mul_f32_dpp %5, %13, %5 row_shl:15 row_mask:0xf bank_mask:0xf\n v_mul_f32_dpp %7, %15, %7 row_shl:15 row_mask:0xf bank_mask:0xf\n"
                LRU_STEP("row_shr:1") LRU_STEP("row_shr:2") LRU_STEP("row_shr:4") LRU_STEP("row_shr:8")
                "s_nop 1\n"
                : "+v"(bv[0]), "+v"(av[0]), "+v"(bv[1]), "+v"(av[1]), "+v"(bv[2]), "+v"(av[2]), "+v"(bv[3]), "+v"(av[3])
                : "v"(hprev[cb * 4 + 0]), "v"(pprev[cb * 4 + 0]), "v"(hprev[cb * 4 + 1]), "v"(pprev[cb * 4 + 1]), "v"(hprev[cb * 4 + 2]), "v"(pprev[cb * 4 + 2]), "v"(hprev[cb * 4 + 3]), "v"(pprev[cb * 4 + 3]));
#undef LRU_STEP
#pragma unroll
            for (int j = 0; j < 4; ++j) { hprev[cb * 4 + j] = bv[j]; pprev[cb * 4 + j] = av[j]; }
        }
        const size_t ro = (size_t)(tok0 + t) * LRUW;
        *(u32x4*)(HL + ro + chA) = pack8(hprev); *(u32x4*)(HL + ro + chB) = pack8(hprev + 8);
        *(u32x4*)(PC + ro + chA) = pack8(pprev); *(u32x4*)(PC + ro + chB) = pack8(pprev + 8);
    }
    if (tl == 15) {
        float* ag = AGG + (size_t)(b * 32 + nb) * 2 * LRUW;
#pragma unroll
        for (int i = 0; i < 16; ++i) { const int ch = (i < 8 ? chA : chB - 8) + i; ag[ch] = pprev[i]; ag[LRUW + ch] = hprev[i]; }
    }
}

template <bool SWA>
__device__ __forceinline__ void p2_attn(const Params& p, unsigned char* lds, int b, int nb) {
    constexpr int NKV = SWA ? 2 : 4, GQ = SWA ? 2 : 1, NKB = SWA ? 10 : 16;
    constexpr int QCOL = SWA ? C_SQ : C_XQ, GCOL = SWA ? C_SG : C_XG, YOFF = SWA ? 512 : 768;
    const int tid = fresh_tid(), lane = tid & 63, w = tid >> 6, q = lane >> 4, tl = lane & 15;
    const u16* proj = (const u16*)(p.ws + WS_PROJ); const u16* mkv = (const u16*)(p.ws + WS_MKV); const float* rope = (const float*)(p.ws + WS_ROPE);
    u16* Y = (u16*)(p.ws + WS_Y);
    const int tok0 = b * SEQ + nb * 128; const int qrow = tok0 + 16 * w + tl;
    u16* Kl = (u16*)lds; u16* Vt = (u16*)(lds + KL_BYTES); u16* Ob = (u16*)(lds + KL_BYTES + VT_BYTES) + w * (16 * OB_PITCH) + tl * OB_PITCH + q * 4;
    const float* gq = SWA ? p.q_norm_g : p.xq_norm_g; const float* gk = SWA ? p.k_norm_g : p.xk_norm_g;
    const int kb0 = SWA ? (w < 6 ? w : 6) : 0;
    float ssq = 0.f;
    const int skey = tid >> 1, shalf = tid & 1;
    const bool svalid = SWA ? ((nb > 0) || (skey >= 128)) : true;
    u32x4 kr[4], vr[4];
    auto kv_load = [&](int kvh) {
        const u16 *ksrc, *vsrc;
        if (SWA) { const u16* rowp = proj + ((long)tok0 + skey - 128) * DIN; ksrc = rowp + C_SK + kvh * 64 + shalf * 32; vsrc = rowp + C_SV + kvh * 64 + shalf * 32; }
        else { const u16* rowp = mkv + (size_t)(b * MEML + skey) * 512; ksrc = rowp + kvh * 64 + shalf * 32; vsrc = rowp + 256 + kvh * 64 + shalf * 32; }
#pragma unroll
        for (int i = 0; i < 4; ++i) { kr[i] = (u32x4){0u, 0u, 0u, 0u}; vr[i] = kr[i]; }
        if (svalid) {
#pragma unroll
            for (int i = 0; i < 4; ++i) { kr[i] = ((const u32x4*)ksrc)[i]; vr[i] = ((const u32x4*)vsrc)[i]; } }
    };
    u32x4 qr0, qr1, qrp;
    auto q_load = [&](int hh) {
        const u16* qsrc = proj + (size_t)qrow * DIN + QCOL + hh * 64;
        qr0 = *(const u32x4*)(qsrc + q * 8); qr1 = *(const u32x4*)(qsrc + 32 + q * 8);
        if (SWA) qrp = *(const u32x4*)(qsrc + ((q ^ 1) & 1) * 8);
    };
    kv_load(0); q_load(0);
#pragma unroll 1
    for (int kvh = 0; kvh < NKV; ++kvh) {
        __syncthreads();
        {
            float xk[32];
#pragma unroll
            for (int i = 0; i < 4; ++i) unpack8(kr[i], xk + 8 * i);
            float ss = 0.f;
#pragma unroll
            for (int i = 0; i < 32; ++i) ss += xk[i] * xk[i];
            ss += __shfl_xor(ss, 1);
            const float rs = __builtin_amdgcn_rsqf(ss * (1.f / 64.f) + EPS);
#pragma unroll
            for (int i = 0; i < 32; ++i) xk[i] = xk[i] * rs * gk[shalf * 32 + i];
            if (SWA && shalf == 0) {
                int pos = nb * 128 + skey - 128; pos = pos < 0 ? 0 : pos;
                const float* rt = rope + pos * 16;
#pragma unroll
                for (int i = 0; i < 8; ++i) { const float c = rt[i], s = rt[8 + i], x1 = xk[i], x2 = xk[8 + i]; xk[i] = x1 * c - x2 * s; xk[8 + i] = x2 * c + x1 * s; }
            }
            u32x4* kdst = (u32x4*)(Kl + skey * KL_PITCH + shalf * 32);
#pragma unroll
            for (int i = 0; i < 4; ++i) kdst[i] = pack8(xk + 8 * i);
            u16* vdst = Vt + (shalf * 32) * VT_PITCH + skey;
#pragma unroll
            for (int i = 0; i < 4; ++i) {
                const unsigned wv[4] = {vr[i].x, vr[i].y, vr[i].z, vr[i].w};
#pragma unroll
                for (int k2 = 0; k2 < 4; ++k2) { vdst[(8 * i + 2 * k2) * VT_PITCH] = (u16)(wv[k2] & 0xffffu); vdst[(8 * i + 2 * k2 + 1) * VT_PITCH] = (u16)(wv[k2] >> 16); }
            }
        }
        __syncthreads();
        if (kvh + 1 < NKV) kv_load(kvh + 1);
#pragma unroll 1
        for (int g = 0; g < GQ; ++g) {
            const int hh = SWA ? kvh * 2 + g : kvh;
            bf16x8 qf[2];
            {
                float x0[8], x1[8]; unpack8(qr0, x0); unpack8(qr1, x1);
                float ss = 0.f;
#pragma unroll
                for (int i = 0; i < 8; ++i) ss += x0[i] * x0[i] + x1[i] * x1[i];
                ss += __shfl_xor(ss, 16); ss += __shfl_xor(ss, 32);
                const float rs = __builtin_amdgcn_rsqf(ss * (1.f / 64.f) + EPS) * (0.125f * 1.4426950408889634f);
#pragma unroll
                for (int i = 0; i < 8; ++i) { x0[i] = x0[i] * rs * gq[q * 8 + i]; x1[i] = x1[i] * rs * gq[32 + q * 8 + i]; }
                if (SWA) {
                    const float* rt = rope + (nb * 128 + 16 * w + tl) * 16;
                    float xp[8]; unpack8(qrp, xp);
                    const float sg = (q == 0) ? -1.f : ((q == 1) ? 1.f : 0.f);
#pragma unroll
                    for (int i = 0; i < 8; ++i) {
                        const float c = (q < 2) ? rt[i] : 1.f, s = sg * rt[8 + i];
                        x0[i] = x0[i] * c + (xp[i] * rs * gq[((q ^ 1) & 1) * 8 + i]) * s;
                    }
                }
                qf[0] = as_bf16x8(pack8(x0)); qf[1] = as_bf16x8(pack8(x1));
            }
            if (hh + 1 < 4) q_load(hh + 1);
            f32x4 sacc[NKB];
#pragma unroll
            for (int kbi = 0; kbi < NKB; ++kbi) {
                sacc[kbi] = (f32x4){0.f, 0.f, 0.f, 0.f};
                const u16* kp = Kl + ((kb0 + kbi) * 16 + tl) * KL_PITCH + q * 8;
#pragma unroll
                for (int ks = 0; ks < 2; ++ks) { const bf16x8 kf = *(const bf16x8*)(kp + ks * 32); sacc[kbi] = __builtin_amdgcn_mfma_f32_16x16x32_bf16(kf, qf[ks], sacc[kbi], 0, 0, 0); }
            }
            const float sink = SWA ? p.sinks[hh] * 1.4426950408889634f : -1e30f;
            float mx = sink;
            const int qi = 16 * w + tl;
#pragma unroll
            for (int kbi = 0; kbi < NKB; ++kbi)
#pragma unroll
                for (int j = 0; j < 4; ++j) {
                    if (SWA) { const int kj = (kb0 + kbi) * 16 + q * 4 + j; const bool ok = (kj > qi) && (kj <= qi + 128) && ((nb > 0) || (kj >= 128)); if (!ok) sacc[kbi][j] = -1e30f; }
                    mx = fmaxf(mx, sacc[kbi][j]);
                }
            mx = fmaxf(mx, __shfl_xor(mx, 16)); mx = fmaxf(mx, __shfl_xor(mx, 32));
            float sum = 0.f;
#pragma unroll
            for (int kbi = 0; kbi < NKB; ++kbi)
#pragma unroll
                for (int j = 0; j < 4; ++j) { const float pe = __builtin_amdgcn_exp2f(sacc[kbi][j] - mx); sacc[kbi][j] = pe; sum += pe; }
            sum += __shfl_xor(sum, 16); sum += __shfl_xor(sum, 32);
            if (SWA) sum += __builtin_amdgcn_exp2f(sink - mx);
            const float inv = __builtin_amdgcn_rcpf(sum);
            f32x4 oacc[4];
#pragma unroll
            for (int db = 0; db < 4; ++db) oacc[db] = (f32x4){0.f, 0.f, 0.f, 0.f};
#pragma unroll
            for (int kp2 = 0; kp2 < NKB / 2; ++kp2) {
                u32x4 pw; pw.x = pk2(sacc[2 * kp2][0], sacc[2 * kp2][1]); pw.y = pk2(sacc[2 * kp2][2], sacc[2 * kp2][3]); pw.z = pk2(sacc[2 * kp2 + 1][0], sacc[2 * kp2 + 1][1]); pw.w = pk2(sacc[2 * kp2 + 1][2], sacc[2 * kp2 + 1][3]);
                const bf16x8 pf = as_bf16x8(pw);
#pragma unroll
                for (int db = 0; db < 4; ++db) {
                    const u16* vp = Vt + (db * 16 + tl) * VT_PITCH + (kb0 + 2 * kp2) * 16 + q * 4;
                    const u32x2 v0 = *(const u32x2*)vp, v1 = *(const u32x2*)(vp + 16);
                    u32x4 vw; vw.x = v0.x; vw.y = v0.y; vw.z = v1.x; vw.w = v1.y;
                    oacc[db] = __builtin_amdgcn_mfma_f32_16x16x32_bf16(as_bf16x8(vw), pf, oacc[db], 0, 0, 0);
                }
            }
#pragma unroll
            for (int db = 0; db < 4; ++db) {
                const f32x4 o = oacc[db] * inv;
                ssq += (o[0] * o[0] + o[1] * o[1]) + (o[2] * o[2] + o[3] * o[3]);
                u32x2 ow; ow.x = pk2(o[0], o[1]); ow.y = pk2(o[2], o[3]);
                *(u32x2*)(Ob + hh * 64 + db * 16) = ow;
            }
        }
    }
    ssq += __shfl_xor(ssq, 16); ssq += __shfl_xor(ssq, 32);
    const float rs = rsqrtf(ssq * (1.f / 256.f) + EPS);
#pragma unroll
    for (int i = 0; i < 16; ++i) {
        const int c = i * 16 + q * 4;
        const u32x2 ov = *(const u32x2*)(Ob + i * 16);
        const u32x2 gt = *(const u32x2*)(proj + (size_t)qrow * DIN + GCOL + c);
        const f32x4 gn = *(const f32x4*)(p.out_norm_g + YOFF + c);
        u32x2 yo; yo.x = pk2(bflo(ov.x) * rs * gn[0] * silu_f(bflo(gt.x)), bfhi(ov.x) * rs * gn[1] * silu_f(bfhi(gt.x))); yo.y = pk2(bflo(ov.y) * rs * gn[2] * silu_f(bflo(gt.y)), bfhi(ov.y) * rs * gn[3] * silu_f(bfhi(gt.y)));
        *(u32x2*)(Y + (size_t)qrow * DMIX + YOFF + c) = yo;
    }
}
__device__ __forceinline__ void phase2(const Params& p, unsigned char* lds) {
    for (int tile = blockIdx.x; tile < NBATCH * 32; tile += gridDim.x) {
        const int b = tile & 7, nb = tile >> 3;
        __syncthreads();
        p2_attn<true>(p, lds, b, nb);
        p2_attn<false>(p, lds, b, nb);
        __syncthreads();
        p2_lru(p, lds, b, nb);
    }
}

__device__ __forceinline__ void phase3(const Params& p, unsigned char* lds) {
    const int tid = fresh_tid(), lane = tid & 63, w = tid >> 6;
    const u16* proj = (const u16*)(p.ws + WS_PROJ); const u16* HL = (const u16*)(p.ws + WS_HL); const u16* PC = (const u16*)(p.ws + WS_PC); const float* AGG = (const float*)(p.ws + WS_AGG);
    u16* Y = (u16*)(p.ws + WS_Y);
    float* cl = (float*)lds;
    const int c0 = lane * 8;
    float gn[8];
#pragma unroll
    for (int i = 0; i < 8; ++i) gn[i] = p.out_norm_g[c0 + i];
    for (int tile = blockIdx.x; tile < NBATCH * 32; tile += gridDim.x) {
        const int b = tile & 7, nb = tile >> 3, tok0 = b * SEQ + nb * 128;
        {
            const float* ag = AGG + (size_t)(b * 32) * 2 * LRUW + tid;
            float cy = 0.f;
#pragma unroll 8
            for (int j = 0; j < nb; ++j) { const float pj = ag[(size_t)j * 2 * LRUW], hj = ag[(size_t)j * 2 * LRUW + LRUW]; cy = cy * pj + hj; }
            __syncthreads();
            cl[tid] = cy;
            __syncthreads();
        }
        float carry[8];
        { const f32x4 ca = *(const f32x4*)(cl + c0), cb = *(const f32x4*)(cl + c0 + 4);
#pragma unroll
          for (int i = 0; i < 4; ++i) { carry[i] = ca[i]; carry[4 + i] = cb[i]; } }
#pragma unroll 1
        for (int t4 = 0; t4 < 16; t4 += 4) {
            u32x4 hl[4], pc[4], gt[4]; float ss[4]; float h[4][8];
#pragma unroll
            for (int u = 0; u < 4; ++u) { const size_t row = (size_t)tok0 + w * 16 + t4 + u;
                hl[u] = __builtin_nontemporal_load((const u32x4*)(HL + row * LRUW + c0)); pc[u] = __builtin_nontemporal_load((const u32x4*)(PC + row * LRUW + c0)); gt[u] = __builtin_nontemporal_load((const u32x4*)(proj + row * DIN + C_LRUG + c0)); }
#pragma unroll
            for (int u = 0; u < 4; ++u) { float pf[8]; unpack8(hl[u], h[u]); unpack8(pc[u], pf); ss[u] = 0.f;
#pragma unroll
                for (int i = 0; i < 8; ++i) { h[u][i] = h[u][i] + pf[i] * carry[i]; ss[u] += h[u][i] * h[u][i]; } }
#pragma unroll
            for (int o = 1; o < 64; o <<= 1) {
#pragma unroll
                for (int u = 0; u < 4; ++u) ss[u] += __shfl_xor(ss[u], o); }
#pragma unroll
            for (int u = 0; u < 4; ++u) { const size_t row = (size_t)tok0 + w * 16 + t4 + u;
                const float rs = rsqrtf(ss[u] * (1.f / LRUW) + EPS); float gf[8], yv[8]; unpack8(gt[u], gf);
#pragma unroll
                for (int i = 0; i < 8; ++i) yv[i] = h[u][i] * rs * gn[i] * silu_f(gf[i]);
                *(u32x4*)(Y + row * DMIX + c0) = pack8(yv); }
        }
    }
}

#define XB_TMO      128
#define XB_XCNT(j)  (256  + 64 * (j))
#define XB_XSUB(j)  (1280 + 64 * (j))
#define XB_XGEN(j)  (2304 + 64 * (j))
#define XB_TOP      3328
#define XB_TOPGEN   3392
#define XCD_BAR_WORDS 3456
#define XB_SPIN_CAP (1u << 18)
#define LAS __attribute__((address_space(3)))

__device__ __forceinline__ unsigned xb_ld(unsigned* p)              { return __hip_atomic_load(p, __ATOMIC_RELAXED, __HIP_MEMORY_SCOPE_AGENT); }
__device__ __forceinline__ unsigned xb_add(unsigned* p, unsigned v) { return __hip_atomic_fetch_add(p, v, __ATOMIC_RELAXED, __HIP_MEMORY_SCOPE_AGENT); }
__device__ __forceinline__ unsigned xb_xcc_id() { return (unsigned)__builtin_amdgcn_s_getreg((3 << 11) | 20) & 0xFu; }
#define XB_SPIN(cond, bar) do { unsigned _sp = 0; while (cond) { __builtin_amdgcn_s_sleep(1); \
    if ((++_sp & 255u) == 0u) { if (xb_ld(&(bar)[XB_TMO])) break; if (_sp > XB_SPIN_CAP) { atomicAdd(&(bar)[XB_TMO], 1u); break; } } } } while (0)

struct XcdBarrier {
    unsigned* bar; unsigned x;
    volatile LAS unsigned* st;
};

__device__ __forceinline__ XcdBarrier xcd_barrier_post(unsigned* bar, volatile LAS unsigned* st) {
    XcdBarrier b; b.bar = bar; b.x = xb_xcc_id(); b.st = st;
    if (threadIdx.x == 0) (void)xb_add(&bar[XB_XCNT(b.x)], 1u);
    return b;
}
__device__ __forceinline__ void xcd_barrier_complete(unsigned* bar, unsigned x, unsigned& nloc, unsigned& nx) {
    const unsigned G = gridDim.x * gridDim.y * gridDim.z;
    unsigned sum, cnt, mine, sp = 0u;
    for (;;) {
        sum = 0u; cnt = 0u; mine = 0u;
#pragma unroll
        for (unsigned j = 0; j < 16; ++j) { const unsigned c = xb_ld(&bar[XB_XCNT(j)]); sum += c; cnt += (c > 0u) ? 1u : 0u; mine = (j == x) ? c : mine; }
        if (sum == G) break;
        __builtin_amdgcn_s_sleep(1);
        if ((++sp & 255u) == 0u) { if (xb_ld(&bar[XB_TMO])) break; if (sp > XB_SPIN_CAP) { atomicAdd(&bar[XB_TMO], 1u); break; } }
    }
    nloc = mine > 0u ? mine : 1u; nx = cnt > 0u ? cnt : 1u;
}

__device__ __forceinline__ void xcd_barrier(const XcdBarrier& b) {
    asm volatile("s_waitcnt vmcnt(0)" ::: "memory");
    __syncthreads();
    if (threadIdx.x == 0) {
        unsigned* bar = b.bar;
        __builtin_amdgcn_s_waitcnt(0);
        unsigned nloc = b.st[0], nx = b.st[1];
        if (nloc == 0u) { xcd_barrier_complete(bar, b.x, nloc, nx); b.st[0] = nloc; b.st[1] = nx; }
        const unsigned old = xb_add(&bar[XB_XSUB(b.x)], 1u);
        const unsigned gen = old / nloc;
        if (old + 1u == (gen + 1u) * nloc) {
            __builtin_amdgcn_fence(__ATOMIC_RELEASE, "agent");
            asm volatile("s_waitcnt vmcnt(0)" ::: "memory");
            const unsigned og = xb_add(&bar[XB_TOP], 1u);
            const unsigned tg = og / nx;
            if (og + 1u == (tg + 1u) * nx) xb_add(&bar[XB_TOPGEN], 1u);
            else XB_SPIN(xb_ld(&bar[XB_TOPGEN]) == tg, bar);
            __builtin_amdgcn_fence(__ATOMIC_ACQUIRE, "agent");
            xb_add(&bar[XB_XGEN(b.x)], 1u);
            asm volatile("s_waitcnt vmcnt(0)" ::: "memory");
        } else {
            XB_SPIN(xb_ld(&bar[XB_XGEN(b.x)]) == gen, bar);
            __builtin_amdgcn_fence(__ATOMIC_ACQUIRE, "agent");
            asm volatile("s_waitcnt vmcnt(0)" ::: "memory");
        }
    }
    __syncthreads();
}

__global__ void __launch_bounds__(NTHREADS, 2) k_mega(Params p) {
    extern __shared__ __attribute__((aligned(16))) unsigned char lds[];
    volatile LAS unsigned* st = (volatile LAS unsigned*)(lds + LDS_BYTES - 16);
    if (threadIdx.x < 4) st[threadIdx.x] = 0u;
    __syncthreads();
    (void)xcd_barrier_post((unsigned*)(p.ws + WS_BAR), st);
#define GRID_BAR() do { XcdBarrier b_; b_.bar = (unsigned*)(p.ws + WS_BAR); b_.x = xb_xcc_id(); b_.st = (volatile LAS unsigned*)(lds + LDS_BYTES - 16); xcd_barrier(b_); } while (0)
    phase0(p, lds); GRID_BAR();
    phase1(p, lds); GRID_BAR();
    phase2(p, lds); GRID_BAR();
    phase3(p, lds); GRID_BAR();
    phase4(p, lds);
}

extern "C" void kernel_launch(void* const* d_in, const int* in_sizes, int n_in, void* d_out, int out_size, void* d_ws, size_t ws_size, hipStream_t stream) {
    static int grid = 0;
    if (grid == 0) {
        if (n_in != 20 || out_size != T_TOK * DM || ws_size < WS_END) { fprintf(stderr, "kernel_launch: unexpected shapes (n_in %d out %d ws %zu)\n", n_in, out_size, ws_size); grid = -1; return; }
        int dev = 0, cus = 0, per_cu = 0;
        hipGetDevice(&dev); hipDeviceGetAttribute(&cus, hipDeviceAttributeMultiprocessorCount, dev);
        hipFuncSetAttribute((const void*)k_mega, hipFuncAttributeMaxDynamicSharedMemorySize, LDS_BYTES);
        hipOccupancyMaxActiveBlocksPerMultiprocessor(&per_cu, (const void*)k_mega, NTHREADS, LDS_BYTES);
        if (per_cu < 1) { fprintf(stderr, "kernel_launch: occupancy query says %d blocks per CU\n", per_cu); per_cu = 1; }
        if (per_cu > 1) per_cu = 1;
        grid = cus * per_cu;
        (void)hipGetLastError();
    }
    if (grid < 0) return;
    Params p{};
    p.x = (const float*)d_in[0]; p.mem = (const float*)d_in[1]; p.norm_g = (const float*)d_in[2]; p.mem_norm_g = (const float*)d_in[3]; p.w_in = (const float*)d_in[4];
    p.conv_w = (const float*)d_in[5]; p.conv_b = (const float*)d_in[6]; p.w_rg = (const float*)d_in[7]; p.b_rg = (const float*)d_in[8]; p.w_ig = (const float*)d_in[9]; p.b_ig = (const float*)d_in[10];
    p.lam = (const float*)d_in[11]; p.q_norm_g = (const float*)d_in[12]; p.k_norm_g = (const float*)d_in[13]; p.sinks = (const float*)d_in[14]; p.w_mem_kv = (const float*)d_in[15];
    p.xq_norm_g = (const float*)d_in[16]; p.xk_norm_g = (const float*)d_in[17]; p.out_norm_g = (const float*)d_in[18]; p.w_out = (const float*)d_in[19];
    p.out = (float*)d_out; p.ws = (unsigned char*)d_ws;
    if (hipMemsetAsync((char*)d_ws + WS_BAR, 0, 16384, stream) != hipSuccess) { fprintf(stderr, "kernel_launch: memset failed\n"); return; }
    hipLaunchKernelGGL(k_mega, dim3(grid), dim3(NTHREADS), LDS_BYTES, stream, p);
    const hipError_t e = hipPeekAtLastError();
    if (e != hipSuccess) fprintf(stderr, "launch failed: %s (grid %d)\n", hipGetErrorString(e), grid);
}
```

```cpp
#include <hip/hip_runtime.h>
#include <cstdio>
#include <cstdint>

namespace pg8 {
#define PG8_LAS __attribute__((address_space(3)))
typedef unsigned short bf16_t;
typedef short bf16x8 __attribute__((ext_vector_type(8)));
typedef float f32x4 __attribute__((ext_vector_type(4)));
typedef unsigned u32x4 __attribute__((ext_vector_type(4)));
constexpr int BM = 256, BK = 64, HALF = 128, HTB = HALF * BK * 2  , STAGE_BYTES = 8 * HTB, NXCD = 8, WGM = 8;

__host__ __device__ __forceinline__ int lds_byte(int r, int c) { const int st = (r >> 4) * 2 + (c >> 5), rr = r & 15, cc = c & 31, ob = rr * 64 + cc * 2; return st * 1024 + (ob ^ (((ob >> 9) & 1) << 5)); }
__host__ __device__ __forceinline__ void stage_rc(int b, int& R, int& C) { const int st = b / 1024, sb = b % 1024, swz = sb ^ (((sb >> 9) & 1) << 5); R = (st >> 1) * 16 + swz / 64; C = (st & 1) * 32 + (swz % 64) / 2; }
__host__ __device__ __forceinline__ int perm32(int rho) { const int n = rho >> 4, i = rho & 15; return 8 * (i >> 2) + 4 * n + (i & 3); }

struct Unit { int pm, pn; };
struct Gemm { const bf16_t* A; const bf16_t* Bt; int M, N, K; };

struct StaticOrder {
    int nM, nN, nwg, G, c, nextra, xpm0, xpn0, xw;
    __host__ __device__ void init(int M, int N, int G_, int c_) { nM = M / BM; nN = N / BM; nwg = nM * nN; G = G_; c = c_; nextra = 0; xpm0 = 0; xpn0 = 0; xw = 1; }
    __host__ __device__ bool next(int i, Unit& u) const {
        const long L = (long)i * G + c; if (L >= nwg + nextra) return false;
        if (L >= nwg) { const int j = (int)L - nwg; u.pm = xpm0 + j / xw; u.pn = xpn0 + j % xw; return true; }
        int wgid = (int)L; { const int q = nwg / NXCD, r = nwg % NXCD, xcd = wgid % NXCD, off = wgid / NXCD; wgid = (xcd < r ? xcd * (q + 1) : r * (q + 1) + (xcd - r) * q) + off; }
        const int nig = WGM * nN, gid = wgid / nig, fm = gid * WGM, gsz = (nM - fm) < WGM ? (nM - fm) : WGM;
        u.pm = fm + ((wgid % nig) % gsz); u.pn = (wgid % nig) / gsz; return true;
    }
    __device__ __forceinline__ void a_ready(const Unit&) const {}
    __device__ __forceinline__ void done(const Unit&) const {}
};
__device__ __forceinline__ unsigned cvt_pk_bf16(float lo, float hi) { unsigned r; asm("v_cvt_pk_bf16_f32 %0, %1, %2" : "=v"(r) : "v"(lo), "v"(hi)); return r; }

template <class Epi, class Sched, bool ALIGN_EPI = false, bool SP2 = false>
__device__ __forceinline__ void gemm_phase(PG8_LAS unsigned char* lds, const Gemm g, const Sched& S, const Epi& E) {
    int tid = threadIdx.x; asm volatile("" : "+v"(tid));
    const int wid = __builtin_amdgcn_readfirstlane(tid >> 6), lane = tid & 63, wr = wid >> 2, wc = wid & 3, fr = lane & 15, fq = lane >> 4;
    const int K = g.K, nt = K / BK;
    unsigned voffA[2], voffB[2];
#pragma unroll
    for (int i = 0; i < 2; ++i) { int R, C; stage_rc(tid * 16 + i * 8192, R, C); const int Rb = Epi::PERM ? ((R & ~31) + perm32(R & 31)) : R;
        voffA[i] = (unsigned)(R * K + C) * 2u; voffB[i] = (unsigned)(Rb * K + C) * 2u; }
    const size_t kstep = (size_t)(BK * 2);
    const size_t hstep = (size_t)HALF * K * 2;
    const size_t tstep = 2 * hstep;
    const unsigned ldsw = (unsigned)wid * 1024u;
    const int aoff = lds_byte(wr * 64 + fr, fq * 8), boff = lds_byte(wc * 32 + fr, fq * 8);
#define PG8_SA(b, h) (((b) * 2 + (h)) * HTB)
#define PG8_SB(b, h) ((4 + (b) * 2 + (h)) * HTB)
#define PG8_STAGE(bufoff, gbase, voff) do { _Pragma("unroll") for (int _i = 0; _i < 2; ++_i) \
        __builtin_amdgcn_global_load_lds((const unsigned*)((const char*)(gbase) + (voff)[_i]), (PG8_LAS unsigned*)(lds + (bufoff) + ldsw + _i * 8192), 16, 0, 0); } while (0)
#define PG8_LDA(dst, b, h) do { _Pragma("unroll") for (int m = 0; m < 4; ++m) _Pragma("unroll") for (int k = 0; k < 2; ++k) dst[m][k] = *(const PG8_LAS bf16x8*)(lds + PG8_SA(b, h) + aoff + m * 2048 + k * 1024); } while (0)
#define PG8_LDB(dst, b, h) do { _Pragma("unroll") for (int n = 0; n < 2; ++n) _Pragma("unroll") for (int k = 0; k < 2; ++k) dst[n][k] = *(const PG8_LAS bf16x8*)(lds + PG8_SB(b, h) + boff + n * 2048 + k * 1024); } while (0)
#define PG8_MMA(ai, bj, At, Bt) do { __builtin_amdgcn_s_setprio(1); _Pragma("unroll") for (int m = 0; m < 4; ++m) _Pragma("unroll") for (int n = 0; n < 2; ++n) _Pragma("unroll") for (int k = 0; k < 2; ++k) \
        acc[ai][bj][m][n] = __builtin_amdgcn_mfma_f32_16x16x32_bf16(Bt[n][k], At[m][k], acc[ai][bj][m][n], 0, 0, 0); __builtin_amdgcn_s_setprio(0); } while (0)
#define PG8_WAIT_V(n) asm volatile("s_waitcnt vmcnt(" #n ")" ::: "memory")
#define PG8_WAIT_L(n) asm volatile("s_waitcnt lgkmcnt(" #n ")" ::: "memory")
#define PG8_BAR __builtin_amdgcn_s_barrier()
#define PG8_SCHED __builtin_amdgcn_sched_barrier(0)
    Unit cur, nxt; int ui = 0;
    if (!S.next(0, cur)) return;
    f32x4 acc[2][2][4][2];
#pragma unroll
    for (int a = 0; a < 2; ++a)
#pragma unroll
        for (int b = 0; b < 2; ++b)
#pragma unroll
            for (int m = 0; m < 4; ++m)
#pragma unroll
                for (int n = 0; n < 2; ++n) acc[a][b][m][n] = (f32x4){0.f, 0.f, 0.f, 0.f};
    bf16x8 At[4][2], B0[2][2], B1[2][2];
    const char* cA = (const char*)g.A + (size_t)cur.pm * tstep; const char* cB = (const char*)g.Bt + (size_t)cur.pn * tstep;
    S.a_ready(cur);
    if constexpr (SP2) {
        PG8_STAGE(PG8_SB(0, 0), cB, voffB); PG8_STAGE(PG8_SB(0, 1), cB + hstep, voffB); PG8_STAGE(PG8_SA(0, 0), cA, voffA); PG8_STAGE(PG8_SA(0, 1), cA + hstep, voffA);
        if (wr == 1) PG8_BAR;
        PG8_WAIT_V(2); PG8_BAR;
        PG8_STAGE(PG8_SB(1, 0), cB + kstep, voffB); PG8_STAGE(PG8_SA(1, 0), cA + kstep, voffA); PG8_STAGE(PG8_SB(1, 1), cB + hstep + kstep, voffB);
        PG8_WAIT_V(6); PG8_BAR;
    } else {
        PG8_STAGE(PG8_SB(0, 0), cB, voffB); PG8_STAGE(PG8_SA(0, 0), cA, voffA); PG8_STAGE(PG8_SB(0, 1), cB + hstep, voffB); PG8_STAGE(PG8_SA(0, 1), cA + hstep, voffA);
        if (wr == 1) PG8_BAR;
        PG8_WAIT_V(4); PG8_BAR;
        PG8_STAGE(PG8_SB(1, 0), cB + kstep, voffB); PG8_STAGE(PG8_SA(1, 0), cA + kstep, voffA); PG8_STAGE(PG8_SB(1, 1), cB + hstep + kstep, voffB);
        PG8_WAIT_V(6); PG8_BAR;
    }
    for (;;) {
        const bool has_next = S.next(ui + 1, nxt);
        const char* nA = has_next ? (const char*)g.A + (size_t)nxt.pm * tstep : cA; const char* nB = has_next ? (const char*)g.Bt + (size_t)nxt.pn * tstep : cB;
        for (int t = 0; t < nt; t += 2) {
            const bool last = (t == nt - 2);
            const char* a1 = cA + (size_t)(t + 1) * kstep;
            const char* a2 = last ? nA : cA + (size_t)(t + 2) * kstep; const char* b2 = last ? nB : cB + (size_t)(t + 2) * kstep;
            const char* a3 = a2 + kstep; const char* b3 = b2 + kstep;
            if (last && has_next) S.a_ready(nxt);
            if constexpr (SP2) {
            PG8_LDB(B0, 0, 0); PG8_LDB(B1, 0, 1); PG8_SCHED; PG8_LDA(At, 0, 0); PG8_STAGE(PG8_SA(1, 1), a1 + hstep, voffA);
            PG8_WAIT_V(8); PG8_WAIT_L(0); PG8_BAR; PG8_MMA(0, 0, At, B0); PG8_MMA(0, 1, At, B1); PG8_BAR; PG8_SCHED;
            PG8_LDA(At, 0, 1); PG8_STAGE(PG8_SB(0, 0), b2, voffB); PG8_STAGE(PG8_SB(0, 1), b2 + hstep, voffB); PG8_STAGE(PG8_SA(0, 0), a2, voffA);
            PG8_WAIT_V(8); PG8_WAIT_L(0); PG8_BAR; PG8_MMA(1, 0, At, B0); PG8_MMA(1, 1, At, B1); PG8_BAR; PG8_SCHED;
            PG8_LDB(B0, 1, 0); PG8_LDB(B1, 1, 1); PG8_SCHED; PG8_LDA(At, 1, 0); PG8_STAGE(PG8_SA(0, 1), a2 + hstep, voffA);
            PG8_WAIT_V(8); PG8_WAIT_L(0); PG8_BAR; PG8_MMA(0, 0, At, B0); PG8_MMA(0, 1, At, B1); PG8_BAR; PG8_SCHED;
            PG8_LDA(At, 1, 1); PG8_STAGE(PG8_SB(1, 0), b3, voffB); PG8_STAGE(PG8_SB(1, 1), b3 + hstep, voffB); PG8_STAGE(PG8_SA(1, 0), a3, voffA);
            PG8_WAIT_V(8); PG8_WAIT_L(0); PG8_BAR; PG8_MMA(1, 0, At, B0); PG8_MMA(1, 1, At, B1); PG8_BAR; PG8_SCHED;
            } else {
            PG8_LDB(B0, 0, 0); PG8_SCHED; PG8_LDA(At, 0, 0); PG8_STAGE(PG8_SA(1, 1), a1 + hstep, voffA);
            PG8_WAIT_L(8); PG8_BAR; PG8_WAIT_L(0); PG8_MMA(0, 0, At, B0); PG8_BAR; PG8_SCHED;
            PG8_LDB(B1, 0, 1); PG8_STAGE(PG8_SB(0, 0), b2, voffB);
            PG8_BAR; PG8_WAIT_L(0); PG8_MMA(0, 1, At, B1); PG8_BAR;
            PG8_LDA(At, 0, 1); PG8_STAGE(PG8_SA(0, 0), a2, voffA);
            PG8_BAR; PG8_WAIT_L(0); PG8_MMA(1, 0, At, B0); PG8_BAR; PG8_SCHED;
            PG8_STAGE(PG8_SB(0, 1), b2 + hstep, voffB);
            PG8_WAIT_V(6); PG8_BAR; PG8_MMA(1, 1, At, B1); PG8_BAR;
            PG8_LDB(B0, 1, 0); PG8_SCHED; PG8_LDA(At, 1, 0); PG8_STAGE(PG8_SA(0, 1), a2 + hstep, voffA);
            PG8_WAIT_L(8); PG8_BAR; PG8_WAIT_L(0); PG8_MMA(0, 0, At, B0); PG8_BAR; PG8_SCHED;
            PG8_LDB(B1, 1, 1); PG8_STAGE(PG8_SB(1, 0), b3, voffB);
            PG8_BAR; PG8_WAIT_L(0); PG8_MMA(0, 1, At, B1); PG8_BAR;
            PG8_LDA(At, 1, 1); PG8_STAGE(PG8_SA(1, 0), a3, voffA);
            PG8_BAR; PG8_WAIT_L(0); PG8_MMA(1, 0, At, B0); PG8_BAR; PG8_SCHED;
            PG8_STAGE(PG8_SB(1, 1), b3 + hstep, voffB);
            PG8_WAIT_V(6); PG8_BAR; PG8_MMA(1, 1, At, B1); PG8_BAR;
            }
        }
        if constexpr (ALIGN_EPI) { if (wr == 0) PG8_BAR; }
        if constexpr (!Epi::AFTER_DRAIN) { E(acc, cur, wr, wc, fr, fq); S.done(cur); }
        if (!has_next) break;
#pragma unroll
        for (int a = 0; a < 2; ++a)
#pragma unroll
            for (int b = 0; b < 2; ++b)
#pragma unroll
                for (int m = 0; m < 4; ++m)
#pragma unroll
                    for (int n = 0; n < 2; ++n) acc[a][b][m][n] = (f32x4){0.f, 0.f, 0.f, 0.f};
        cur = nxt; cA = nA; cB = nB; ++ui;
        if constexpr (ALIGN_EPI) { if (wr == 1) PG8_BAR; }
    }
    PG8_WAIT_V(0);
    if constexpr (!ALIGN_EPI) { if (wr == 0) PG8_BAR; }
    PG8_BAR;
    if constexpr (Epi::AFTER_DRAIN) { E.fused(acc, cur, wr, wc, fr, fq, lds, wid, lane); S.done(cur); }
#undef PG8_SA
#undef PG8_SB
#undef PG8_STAGE
#undef PG8_LDA
#undef PG8_LDB
#undef PG8_MMA
#undef PG8_WAIT_V
#undef PG8_WAIT_L
#undef PG8_BAR
#undef PG8_SCHED
}
}

typedef unsigned short u16;
typedef pg8::bf16x8 bf16x8;
typedef pg8::f32x4 f32x4;
typedef pg8::u32x4 u32x4;
typedef unsigned u32x2 __attribute__((ext_vector_type(2)));
typedef float f32x2 __attribute__((ext_vector_type(2)));

constexpr int T_TOK = 32768, SEQ = 4096, NBATCH = 8, DM = 1024, DIN = 2304, MEMT = 2048, MEML = 256, DMIX = 1024, LRUW = 512;
constexpr int C_LRUX = 0, C_LRUG = 512, C_SQ = 1024, C_SK = 1280, C_SV = 1408, C_SG = 1536, C_XQ = 1792, C_XG = 2048;
constexpr float EPS = 1e-6f;
constexpr int NTHREADS = 512, LDS_BYTES = 147520;

constexpr size_t WS_A1 = 0;
constexpr size_t WS_BT1 = WS_A1 + (size_t)(T_TOK + MEMT) * DM * 2;
constexpr size_t WS_BT2 = WS_BT1 + (size_t)(DIN + 512) * DM * 2;
constexpr size_t WS_WG = WS_BT2 + (size_t)DM * DMIX * 2;
constexpr size_t WS_ROPE = WS_WG + (size_t)2 * 8 * 64 * 64 * 2;
constexpr size_t WS_PROJ = WS_ROPE + (size_t)SEQ * 16 * 4;
constexpr size_t WS_MKV = WS_PROJ + (size_t)T_TOK * DIN * 2;
constexpr size_t WS_Y = WS_MKV + (size_t)MEMT * 512 * 2;
constexpr size_t WS_HL = WS_Y + (size_t)T_TOK * DMIX * 2;
constexpr size_t WS_PC = WS_HL + (size_t)T_TOK * LRUW * 2;
constexpr size_t WS_AGG = WS_PC + (size_t)T_TOK * LRUW * 2;
constexpr size_t WS_BAR = WS_AGG + (size_t)NBATCH * 32 * 2 * LRUW * 4;
constexpr size_t WS_END = WS_BAR + 16384;

struct Params {
    const float *x, *mem, *norm_g, *mem_norm_g, *w_in, *conv_w, *conv_b, *w_rg, *b_rg, *w_ig, *b_ig, *lam, *q_norm_g, *k_norm_g, *sinks, *w_mem_kv, *xq_norm_g, *xk_norm_g, *out_norm_g, *w_out;
    float* out; unsigned char* ws;
};

__device__ __forceinline__ int fresh_tid() { int t = threadIdx.x; asm volatile("" : "+v"(t)); return t; }
__device__ __forceinline__ unsigned pk2(float lo, float hi) { return pg8::cvt_pk_bf16(lo, hi); }
__device__ __forceinline__ float bflo(unsigned u) { return __uint_as_float(u << 16); }
__device__ __forceinline__ float bfhi(unsigned u) { return __uint_as_float(u & 0xffff0000u); }
__device__ __forceinline__ void unpack8(const u32x4 v, float* f) { f[0] = bflo(v.x); f[1] = bfhi(v.x); f[2] = bflo(v.y); f[3] = bfhi(v.y); f[4] = bflo(v.z); f[5] = bfhi(v.z); f[6] = bflo(v.w); f[7] = bfhi(v.w); }
__device__ __forceinline__ u32x4 pack8(const float* f) { u32x4 r; r.x = pk2(f[0], f[1]); r.y = pk2(f[2], f[3]); r.z = pk2(f[4], f[5]); r.w = pk2(f[6], f[7]); return r; }
__device__ __forceinline__ bf16x8 as_bf16x8(u32x4 v) { union { u32x4 u; bf16x8 b; } c; c.u = v; return c.b; }
__device__ __forceinline__ float wave_sum(float v) {
#pragma unroll
    for (int o = 1; o < 64; o <<= 1) v += __shfl_xor(v, o);
    return v;
}
__device__ __forceinline__ float sigmoid_f(float x) { return __builtin_amdgcn_rcpf(1.f + __expf(-x)); }
__device__ __forceinline__ float silu_f(float x) { return x * sigmoid_f(x); }

struct EpiProj {
    static constexpr bool PERM = true, AFTER_DRAIN = false;
    u16* proj; u16* mkv;
    __device__ __forceinline__ void operator()(const f32x4 (&acc)[2][2][4][2], const pg8::Unit& u, int wr, int wc, int fr, int fq) const {
        const int row0 = u.pm * 256 + wr * 64 + fr; u16* base; int ld;
        if (u.pn < 9) { ld = DIN; base = proj + (size_t)row0 * DIN + u.pn * 256; }
        else { ld = 512; base = mkv + (size_t)(row0 - T_TOK) * 512 + (u.pn - 9) * 256; }
        base += wc * 32 + 8 * fq;
#pragma unroll
        for (int ai = 0; ai < 2; ++ai)
#pragma unroll
            for (int m = 0; m < 4; ++m) { u16* rowp = base + (size_t)(ai * 128 + m * 16) * ld;
#pragma unroll
                for (int bj = 0; bj < 2; ++bj) { const f32x4 v0 = acc[ai][bj][m][0], v1 = acc[ai][bj][m][1];
                    u32x4 w; w.x = pk2(v0[0], v0[1]); w.y = pk2(v0[2], v0[3]); w.z = pk2(v1[0], v1[1]); w.w = pk2(v1[2], v1[3]);
                    *(u32x4*)(rowp + bj * 128) = w; } }
    }
};
struct EpiOut {
    static constexpr bool PERM = false, AFTER_DRAIN = false;
    float* out; const float* x;
    __device__ __forceinline__ void operator()(const f32x4 (&acc)[2][2][4][2], const pg8::Unit& u, int wr, int wc, int fr, int fq) const {
        const int row0 = u.pm * 256 + wr * 64 + fr, col0 = u.pn * 256 + wc * 32 + 4 * fq;
#pragma unroll
        for (int ai = 0; ai < 2; ++ai) {
            f32x4 r[4][2][2];
#pragma unroll
            for (int m = 0; m < 4; ++m) { const size_t off = (size_t)(row0 + ai * 128 + m * 16) * DM + col0;
#pragma unroll
                for (int bj = 0; bj < 2; ++bj)
#pragma unroll
                    for (int n = 0; n < 2; ++n) r[m][bj][n] = *(const f32x4*)(x + off + bj * 128 + n * 16); }
            asm volatile("" ::: "memory");
#pragma unroll
            for (int m = 0; m < 4; ++m) { const size_t off = (size_t)(row0 + ai * 128 + m * 16) * DM + col0;
#pragma unroll
                for (int bj = 0; bj < 2; ++bj)
#pragma unroll
                    for (int n = 0; n < 2; ++n) *(f32x4*)(out + off + bj * 128 + n * 16) = acc[ai][bj][m][n] + r[m][bj][n]; }
        }
    }
};

__device__ __forceinline__ void p0_transpose_item(const float* W, int K, int N, u16* WT, int row_off, float* scr, int item, int lane) {
    const int nblk = N / 32, kb = item / nblk, nb = item % nblk, k0 = 64 * kb, n0 = 32 * nb;
#pragma unroll 8
    for (int i = 0; i < 32; ++i) { const int kk = 2 * i + (lane >> 5); scr[kk * 33 + (lane & 31)] = __builtin_nontemporal_load(W + (size_t)(k0 + kk) * N + n0 + (lane & 31)); }
    __builtin_amdgcn_s_waitcnt(0xc07f); asm volatile("" ::: "memory");
    const int c = lane & 7;
#pragma unroll
    for (int j = 0; j < 4; ++j) { const int n = (lane >> 3) + 8 * j; const float* s = scr + (8 * c) * 33 + n;
        u32x4 o; o.x = pk2(s[0 * 33], s[1 * 33]); o.y = pk2(s[2 * 33], s[3 * 33]); o.z = pk2(s[4 * 33], s[5 * 33]); o.w = pk2(s[6 * 33], s[7 * 33]);
        *(u32x4*)(WT + (size_t)(row_off + n0 + n) * K + k0 + 8 * c) = o; }
    __builtin_amdgcn_s_waitcnt(0xc07f); asm volatile("" ::: "memory");
}
template <int NR>
__device__ __forceinline__ void p0_norm_rows(const float* const (&xrow)[NR], const float* g, u16* const (&orow)[NR], int lane) {
    f32x4 v[NR][4]; float s[NR];
#pragma unroll
    for (int r = 0; r < NR; ++r) { const f32x4* xr = (const f32x4*)xrow[r] + lane;
#pragma unroll
        for (int j = 0; j < 4; ++j) v[r][j] = __builtin_nontemporal_load(xr + 64 * j); }
    const f32x4* gr = (const f32x4*)g + lane; f32x4 gg[4];
#pragma unroll
    for (int j = 0; j < 4; ++j) gg[j] = gr[64 * j];
#pragma unroll
    for (int r = 0; r < NR; ++r) { s[r] = 0.f;
#pragma unroll
        for (int j = 0; j < 4; ++j) s[r] += (v[r][j].x * v[r][j].x + v[r][j].y * v[r][j].y) + (v[r][j].z * v[r][j].z + v[r][j].w * v[r][j].w); }
#pragma unroll
    for (int o = 1; o < 64; o <<= 1) {
#pragma unroll
        for (int r = 0; r < NR; ++r) s[r] += __shfl_xor(s[r], o); }
#pragma unroll
    for (int r = 0; r < NR; ++r) { const float rs = rsqrtf(s[r] * (1.f / DM) + EPS); u32x2* o8 = (u32x2*)orow[r] + lane;
#pragma unroll
        for (int j = 0; j < 4; ++j) { u32x2 o; o.x = pk2(v[r][j].x * rs * gg[j].x, v[r][j].y * rs * gg[j].y); o.y = pk2(v[r][j].z * rs * gg[j].z, v[r][j].w * rs * gg[j].w); o8[64 * j] = o; } }
}
__device__ __forceinline__ void phase0(const Params& p, unsigned char* lds) {
    const int tid = fresh_tid(), lane = tid & 63, wave = tid >> 6;
    const int gw = blockIdx.x * 8 + wave, NGW = gridDim.x * 8;
    float* scr = (float*)(lds + wave * 16384);
    u16* A1 = (u16*)(p.ws + WS_A1); u16* Bt1 = (u16*)(p.ws + WS_BT1); u16* Bt2 = (u16*)(p.ws + WS_BT2); u16* Wg = (u16*)(p.ws + WS_WG); float* rope = (float*)(p.ws + WS_ROPE);
    constexpr int I_IN = 16 * (DIN / 32), I_MKV = 16 * (512 / 32), I_OUT = 16 * (DM / 32);
    for (int it = gw; it < I_IN + I_MKV + I_OUT; it += NGW) {
        if (it < I_IN) p0_transpose_item(p.w_in, DM, DIN, Bt1, 0, scr, it, lane);
        else if (it < I_IN + I_MKV) p0_transpose_item(p.w_mem_kv, DM, 512, Bt1, DIN, scr, it - I_IN, lane);
        else p0_transpose_item(p.w_out, DMIX, DM, Bt2, 0, scr, it - I_IN - I_MKV, lane);
    }
    for (int m = gw; m < T_TOK; m += 4 * NGW) {
        const int m1 = min(m + NGW, T_TOK - 1), m2 = min(m + 2 * NGW, T_TOK - 1), m3 = min(m + 3 * NGW, T_TOK - 1);
        const float* const xr[4] = {p.x + (size_t)m * DM, p.x + (size_t)m1 * DM, p.x + (size_t)m2 * DM, p.x + (size_t)m3 * DM};
        u16* const orr[4] = {A1 + (size_t)m * DM, A1 + (size_t)m1 * DM, A1 + (size_t)m2 * DM, A1 + (size_t)m3 * DM};
        p0_norm_rows<4>(xr, p.norm_g, orr, lane);
    }
    for (int m = gw; m < MEMT; m += NGW) {
        const float* const xr[1] = {p.mem + (size_t)m * DM}; u16* const orr[1] = {A1 + (size_t)(T_TOK + m) * DM};
        p0_norm_rows<1>(xr, p.mem_norm_g, orr, lane);
    }
    const int gt = blockIdx.x * NTHREADS + tid, NGT = gridDim.x * NTHREADS;
    for (int i = gt; i < 2 * 8 * 64 * 64; i += NGT) {
        const int d = i & 63, e = (i >> 6) & 63, n = (i >> 12) & 7, g = i >> 15;
        const float v = (g ? p.w_ig : p.w_rg)[(n * 64 + d) * 64 + e];
        Wg[i] = (u16)(pk2(v, 0.f) & 0xffffu);
    }
    for (int i = gt; i < SEQ * 8; i += NGT) {
        const int pos = i >> 3, j = i & 7;
        const float inv_freq = (float)exp(-(double)j * 0.125 * 13.122363377404328);
        const float ang = (float)pos * inv_freq;
        const double rev = (double)ang * 0.15915494309189535; const double fr = rev - floor(rev);
        const double t4 = fr * 4.0; const double qd = floor(t4 + 0.5); const int quad = ((int)qd) & 3;
        const double xx = (t4 - qd) * 1.5707963267948966, x2 = xx * xx;
        const double sn = xx * (1.0 - x2 / 6.0 * (1.0 - x2 / 20.0 * (1.0 - x2 / 42.0 * (1.0 - x2 / 72.0 * (1.0 - x2 / 110.0 * (1.0 - x2 / 156.0))))));
        const double cs = 1.0 - x2 / 2.0 * (1.0 - x2 / 12.0 * (1.0 - x2 / 30.0 * (1.0 - x2 / 56.0 * (1.0 - x2 / 90.0 * (1.0 - x2 / 132.0)))));
        double co, si;
        if (quad == 0) { co = cs; si = sn; } else if (quad == 1) { co = -sn; si = cs; } else if (quad == 2) { co = -cs; si = -sn; } else { co = sn; si = -cs; }
        rope[pos * 16 + j] = (float)co; rope[pos * 16 + 8 + j] = (float)si;
    }
}

__device__ __forceinline__ void phase1(const Params& p, unsigned char* lds) {
    pg8::Gemm g{(const u16*)(p.ws + WS_A1), (const u16*)(p.ws + WS_BT1), T_TOK + MEMT, DIN + 512, DM};
    pg8::StaticOrder S; S.init(T_TOK, DIN, (int)gridDim.x, (int)blockIdx.x); S.nextra = 16; S.xpm0 = 128; S.xpn0 = 9; S.xw = 2;
    EpiProj E{(u16*)(p.ws + WS_PROJ), (u16*)(p.ws + WS_MKV)};
    pg8::gemm_phase<EpiProj, pg8::StaticOrder, true, true>((PG8_LAS unsigned char*)lds, g, S, E);
}
__device__ __forceinline__ void phase4(const Params& p, unsigned char* lds) {
    pg8::Gemm g{(const u16*)(p.ws + WS_Y), (const u16*)(p.ws + WS_BT2), T_TOK, DM, DMIX};
    pg8::StaticOrder S; S.init(T_TOK, DM, (int)gridDim.x, (int)blockIdx.x);
    EpiOut E{p.out, p.x};
    pg8::gemm_phase<EpiOut, pg8::StaticOrder, true, true>((PG8_LAS unsigned char*)lds, g, S, E);
}

constexpr int KL_PITCH = 72;
constexpr int VT_PITCH = 264;
constexpr int KL_BYTES = 256 * KL_PITCH * 2;
constexpr int VT_BYTES = 64 * VT_PITCH * 2;
constexpr int OB_PITCH = 264;

template <int CTRL> __device__ __forceinline__ float dpp_mov(float oldv, float srcv) {
    return __int_as_float(__builtin_amdgcn_update_dpp(__float_as_int(oldv), __float_as_int(srcv), CTRL, 0xf, 0xf, false));
}
__device__ __forceinline__ void p2_lru(const Params& p, unsigned char* lds, int b, int nb) {
    const int tid = fresh_tid(), lane = tid & 63, n = tid >> 6, q = lane >> 4, tl = lane & 15;
    const u16* proj = (const u16*)(p.ws + WS_PROJ); const u16* Wg = (const u16*)(p.ws + WS_WG);
    u16* HL = (u16*)(p.ws + WS_HL); u16* PC = (u16*)(p.ws + WS_PC); float* AGG = (float*)(p.ws + WS_AGG);
    const int tok0 = b * SEQ + nb * 128;
    float* ctab = (float*)lds;
    {
        const int c = tid; const float l = -p.lam[c];
        const float sp = fmaxf(l, 0.f) + log1pf(__expf(-fabsf(l)));
        f32x4 a = {p.conv_w[c], p.conv_w[512 + c], p.conv_w[1024 + c], p.conv_w[1536 + c]};
        f32x4 b2 = {p.conv_b[c], p.b_rg[c], p.b_ig[c], -8.f * sp};
        *(f32x4*)(ctab + c * 8) = a; *(f32x4*)(ctab + c * 8 + 4) = b2;
    }
    const int chA = n * 64 + q * 8, chB = chA + 32;
    u32x4 ua[4], ub[4];
    auto load_u = [&](int mb) {
#pragma unroll
        for (int tap = 0; tap < 4; ++tap) {
            const int tt = mb * 16 + tl - 3 + tap; const bool valid = (nb > 0) || (tt >= 0);
            ua[tap] = (u32x4){0u, 0u, 0u, 0u}; ub[tap] = ua[tap];
            if (valid) { const u16* src = proj + (size_t)(tok0 + tt) * DIN + C_LRUX; ua[tap] = *(const u32x4*)(src + chA); ub[tap] = *(const u32x4*)(src + chB); }
        }
    };
    load_u(0);
    unsigned char* wl = lds + 16384 + n * 16384;
    {
        const u32x4* wsrc0 = (const u32x4*)(Wg + (size_t)(0 * 8 + n) * 4096); const u32x4* wsrc1 = (const u32x4*)(Wg + (size_t)(1 * 8 + n) * 4096);
#pragma unroll
        for (int k = 0; k < 8; ++k) {
            const int i = k * 64 + lane, e = i >> 3, c = i & 7, sw = (((e >> 3) & 3) << 1) | ((e >> 1) & 1);
            const u32x4 v0 = wsrc0[i], v1 = wsrc1[i];
            *(u32x4*)(wl + e * 128 + ((c ^ sw) << 4)) = v0; *(u32x4*)(wl + 8192 + e * 128 + ((c ^ sw) << 4)) = v1;
        }
    }
    __syncthreads();
    float hprev[16], pprev[16], cbr[16], cbi[16], cnl[16];
#pragma unroll
    for (int i = 0; i < 16; ++i) { hprev[i] = 0.f; pprev[i] = 1.f; const int ch = (i < 8 ? chA : chB - 8) + i; cbr[i] = -1.4426950408889634f * ctab[ch * 8 + 5]; cbi[i] = -1.4426950408889634f * ctab[ch * 8 + 6]; cnl[i] = 1.4426950408889634f * ctab[ch * 8 + 7]; }
#pragma unroll 1
    for (int mb = 0; mb < 8; ++mb) {
        asm volatile("" ::: "memory");
        const int t = mb * 16 + tl;
        float xc[16];
#pragma unroll
        for (int i = 0; i < 16; ++i) xc[i] = ctab[((i < 8 ? chA : chB - 8) + i) * 8 + 4];
#pragma unroll
        for (int tap = 0; tap < 4; ++tap) {
            float fa[8], fb[8]; unpack8(ua[tap], fa); unpack8(ub[tap], fb);
#pragma unroll
            for (int i = 0; i < 8; ++i) { xc[i] += ctab[(chA + i) * 8 + tap] * fa[i]; xc[8 + i] += ctab[(chB + i) * 8 + tap] * fb[i]; }
        }
        bf16x8 bfr[2]; bfr[0] = as_bf16x8(pack8(xc)); bfr[1] = as_bf16x8(pack8(xc + 8));
        f32x4 aR[4], aI[4];
#pragma unroll
        for (int cb = 0; cb < 4; ++cb) {
            const int e = (cb >> 1) * 32 + (tl >> 2) * 8 + (cb & 1) * 4 + (tl & 3), sw = (((e >> 3) & 3) << 1) | ((e >> 1) & 1);
            aR[cb] = (f32x4){0.f, 0.f, 0.f, 0.f}; aI[cb] = aR[cb];
#pragma unroll
            for (int ks = 0; ks < 2; ++ks) {
                const bf16x8 wr_ = *(const bf16x8*)(wl + e * 128 + (((ks * 4 + q) ^ sw) << 4));
                const bf16x8 wi_ = *(const bf16x8*)(wl + 8192 + e * 128 + (((ks * 4 + q) ^ sw) << 4));
                aR[cb] = __builtin_amdgcn_mfma_f32_16x16x32_bf16(wr_, bfr[ks], aR[cb], 0, 0, 0);
                aI[cb] = __builtin_amdgcn_mfma_f32_16x16x32_bf16(wi_, bfr[ks], aI[cb], 0, 0, 0);
            }
        }
        asm volatile("" ::: "memory");
        if (mb < 7) load_u(mb + 1);
#pragma unroll
        for (int cb = 0; cb < 4; ++cb) {
            float av[4], bv[4];
#pragma unroll
            for (int j2 = 0; j2 < 4; j2 += 2) {
                const int i16 = cb * 4 + j2;
                const f32x2 tr = (f32x2){aR[cb][j2], aR[cb][j2 + 1]} * -1.4426950408889634f + (f32x2){cbr[i16], cbr[i16 + 1]};
                const f32x2 ti = (f32x2){aI[cb][j2], aI[cb][j2 + 1]} * -1.4426950408889634f + (f32x2){cbi[i16], cbi[i16 + 1]};
                const f32x2 dr = (f32x2){__builtin_amdgcn_exp2f(tr.x), __builtin_amdgcn_exp2f(tr.y)} + 1.f, di = (f32x2){__builtin_amdgcn_exp2f(ti.x), __builtin_amdgcn_exp2f(ti.y)} + 1.f;
                const f32x2 r = {__builtin_amdgcn_rcpf(dr.x), __builtin_amdgcn_rcpf(dr.y)}, ig = {__builtin_amdgcn_rcpf(di.x), __builtin_amdgcn_rcpf(di.y)};
                const f32x2 la2 = (f32x2){cnl[i16], cnl[i16 + 1]} * r;
                const f32x2 a = {__builtin_amdgcn_exp2f(la2.x), __builtin_amdgcn_exp2f(la2.y)};
                const f32x2 x2 = la2 * 1.3862943611198906f;
                f32x2 ps = x2 * 0.0083333338f + 0.041666668f; ps = ps * x2 + 0.16666667f; ps = ps * x2 + 0.5f; ps = ps * x2 + 1.f;
                const f32x2 om_s = -(x2 * ps), om_l = 1.f - a * a;
                const float om0 = (x2.x > -0.25f) ? om_s.x : om_l.x, om1 = (x2.y > -0.25f) ? om_s.y : om_l.y;
                const f32x2 b2 = (f32x2){__builtin_amdgcn_sqrtf(om0), __builtin_amdgcn_sqrtf(om1)} * (ig * (f32x2){xc[i16], xc[i16 + 1]});
                av[j2] = a.x; av[j2 + 1] = a.y; bv[j2] = b2.x; bv[j2 + 1] = b2.y;
            }
#define LRU_STEP(sh) \
            "v_fmac_f32_dpp %0, %0, %1 " sh " row_mask:0xf bank_mask:0xf\n v_fmac_f32_dpp %2, %2, %3 " sh " row_mask:0xf bank_mask:0xf\n" \
            "v_fmac_f32_dpp %4, %4, %5 " sh " row_mask:0xf bank_mask:0xf\n v_fmac_f32_dpp %6, %6, %7 " sh " row_mask:0xf bank_mask:0xf\n" \
            "v_mul_f32_dpp %1, %1, %1 " sh " row_mask:0xf bank_mask:0xf\n v_mul_f32_dpp %3, %3, %3 " sh " row_mask:0xf bank_mask:0xf\n" \
            "v_mul_f32_dpp %5, %5, %5 " sh " row_mask:0xf bank_mask:0xf\n v_mul_f32_dpp %7, %7, %7 " sh " row_mask:0xf bank_mask:0xf\n"
            asm volatile("s_nop 1\n"
                "v_fmac_f32_dpp %0, %8, %1 row_shl:15 row_mask:0xf bank_mask:0xf\n v_fmac_f32_dpp %2, %10, %3 row_shl:15 row_mask:0xf bank_mask:0xf\n"
                "v_fmac_f32_dpp %4, %12, %5 row_shl:15 row_mask:0xf bank_mask:0xf\n v_fmac_f32_dpp %6, %14, %7 row_shl:15 row_mask:0xf bank_mask:0xf\n"
                "v_mul_f32_dpp %1, %9, %1 row_shl:15 row_mask:0xf bank_mask:0xf\n v_mul_f32_dpp %3, %11, %3 row_shl:15 row_mask:0xf bank_mask:0xf\n"
                "v_mul_f32_dpp %5, %13, %5 row_shl:15 row_mask:0xf bank_mask:0xf\n v_mul_f32_dpp %7, %15, %7 row_shl:15 row_mask:0xf bank_mask:0xf\n"
                LRU_STEP("row_shr:1") LRU_STEP("row_shr:2") LRU_STEP("row_shr:4") LRU_STEP("row_shr:8")
                "s_nop 1\n"
                : "+v"(bv[0]), "+v"(av[0]), "+v"(bv[1]), "+v"(av[1]), "+v"(bv[2]), "+v"(av[2]), "+v"(bv[3]), "+v"(av[3])
                : "v"(hprev[cb * 4 + 0]), "v"(pprev[cb * 4 + 0]), "v"(hprev[cb * 4 + 1]), "v"(pprev[cb * 4 + 1]), "v"(hprev[cb * 4 + 2]), "v"(pprev[cb * 4 + 2]), "v"(hprev[cb * 4 + 3]), "v"(pprev[cb * 4 + 3]));
#undef LRU_STEP
#pragma unroll
            for (int j = 0; j < 4; ++j) { hprev[cb * 4 + j] = bv[j]; pprev[cb * 4 + j] = av[j]; }
        }
        const size_t ro = (size_t)(tok0 + t) * LRUW;
        *(u32x4*)(HL + ro + chA) = pack8(hprev); *(u32x4*)(HL + ro + chB) = pack8(hprev + 8);
        *(u32x4*)(PC + ro + chA) = pack8(pprev); *(u32x4*)(PC + ro + chB) = pack8(pprev + 8);
    }
    if (tl == 15) {
        float* ag = AGG + (size_t)(b * 32 + nb) * 2 * LRUW;
#pragma unroll
        for (int i = 0; i < 16; ++i) { const int ch = (i < 8 ? chA : chB - 8) + i; ag[ch] = pprev[i]; ag[LRUW + ch] = hprev[i]; }
    }
}

template <bool SWA>
__device__ __forceinline__ void p2_attn(const Params& p, unsigned char* lds, int b, int nb) {
    constexpr int NKV = SWA ? 2 : 4, GQ = SWA ? 2 : 1, NKB = SWA ? 10 : 16;
    constexpr int QCOL = SWA ? C_SQ : C_XQ, GCOL = SWA ? C_SG : C_XG, YOFF = SWA ? 512 : 768;
    const int tid = fresh_tid(), lane = tid & 63, w = tid >> 6, q = lane >> 4, tl = lane & 15;
    const u16* proj = (const u16*)(p.ws + WS_PROJ); const u16* mkv = (const u16*)(p.ws + WS_MKV); const float* rope = (const float*)(p.ws + WS_ROPE);
    u16* Y = (u16*)(p.ws + WS_Y);
    const int tok0 = b * SEQ + nb * 128; const int qrow = tok0 + 16 * w + tl;
    u16* Kl = (u16*)lds; u16* Vt = (u16*)(lds + KL_BYTES); u16* Ob = (u16*)(lds + KL_BYTES + VT_BYTES) + w * (16 * OB_PITCH) + tl * OB_PITCH + q * 4;
    const float* gq = SWA ? p.q_norm_g : p.xq_norm_g; const float* gk = SWA ? p.k_norm_g : p.xk_norm_g;
    const int kb0 = SWA ? (w < 6 ? w : 6) : 0;
    float ssq = 0.f;
    const int skey = tid >> 1, shalf = tid & 1;
    const bool svalid = SWA ? ((nb > 0) || (skey >= 128)) : true;
    u32x4 kr[4], vr[4];
    auto kv_load = [&](int kvh) {
        const u16 *ksrc, *vsrc;
        if (SWA) { const u16* rowp = proj + ((long)tok0 + skey - 128) * DIN; ksrc = rowp + C_SK + kvh * 64 + shalf * 32; vsrc = rowp + C_SV + kvh * 64 + shalf * 32; }
        else { const u16* rowp = mkv + (size_t)(b * MEML + skey) * 512; ksrc = rowp + kvh * 64 + shalf * 32; vsrc = rowp + 256 + kvh * 64 + shalf * 32; }
#pragma unroll
        for (int i = 0; i < 4; ++i) { kr[i] = (u32x4){0u, 0u, 0u, 0u}; vr[i] = kr[i]; }
        if (svalid) {
#pragma unroll
            for (int i = 0; i < 4; ++i) { kr[i] = ((const u32x4*)ksrc)[i]; vr[i] = ((const u32x4*)vsrc)[i]; } }
    };
    u32x4 qr0, qr1, qrp;
    auto q_load = [&](int hh) {
        const u16* qsrc = proj + (size_t)qrow * DIN + QCOL + hh * 64;
        qr0 = *(const u32x4*)(qsrc + q * 8); qr1 = *(const u32x4*)(qsrc + 32 + q * 8);
        if (SWA) qrp = *(const u32x4*)(qsrc + ((q ^ 1) & 1) * 8);
    };
    kv_load(0); q_load(0);
#pragma unroll 1
    for (int kvh = 0; kvh < NKV; ++kvh) {
        __syncthreads();
        {
            float xk[32];
#pragma unroll
            for (int i = 0; i < 4; ++i) unpack8(kr[i], xk + 8 * i);
            float ss = 0.f;
#pragma unroll
            for (int i = 0; i < 32; ++i) ss += xk[i] * xk[i];
            ss += __shfl_xor(ss, 1);
            const float rs = __builtin_amdgcn_rsqf(ss * (1.f / 64.f) + EPS);
#pragma unroll
            for (int i = 0; i < 32; ++i) xk[i] = xk[i] * rs * gk[shalf * 32 + i];
            if (SWA && shalf == 0) {
                int pos = nb * 128 + skey - 128; pos = pos < 0 ? 0 : pos;
                const float* rt = rope + pos * 16;
#pragma unroll
                for (int i = 0; i < 8; ++i) { const float c = rt[i], s = rt[8 + i], x1 = xk[i], x2 = xk[8 + i]; xk[i] = x1 * c - x2 * s; xk[8 + i] = x2 * c + x1 * s; }
            }
            u32x4* kdst = (u32x4*)(Kl + skey * KL_PITCH + shalf * 32);
#pragma unroll
            for (int i = 0; i < 4; ++i) kdst[i] = pack8(xk + 8 * i);
            u16* vdst = Vt + (shalf * 32) * VT_PITCH + skey;
#pragma unroll
            for (int i = 0; i < 4; ++i) {
                const unsigned wv[4] = {vr[i].x, vr[i].y, vr[i].z, vr[i].w};
#pragma unroll
                for (int k2 = 0; k2 < 4; ++k2) { vdst[(8 * i + 2 * k2) * VT_PITCH] = (u16)(wv[k2] & 0xffffu); vdst[(8 * i + 2 * k2 + 1) * VT_PITCH] = (u16)(wv[k2] >> 16); }
            }
        }
        __syncthreads();
        if (kvh + 1 < NKV) kv_load(kvh + 1);
#pragma unroll 1
        for (int g = 0; g < GQ; ++g) {
            const int hh = SWA ? kvh * 2 + g : kvh;
            bf16x8 qf[2];
            {
                float x0[8], x1[8]; unpack8(qr0, x0); unpack8(qr1, x1);
                float ss = 0.f;
#pragma unroll
                for (int i = 0; i < 8; ++i) ss += x0[i] * x0[i] + x1[i] * x1[i];
                ss += __shfl_xor(ss, 16); ss += __shfl_xor(ss, 32);
                const float rs = __builtin_amdgcn_rsqf(ss * (1.f / 64.f) + EPS) * (0.125f * 1.4426950408889634f);
#pragma unroll
                for (int i = 0; i < 8; ++i) { x0[i] = x0[i] * rs * gq[q * 8 + i]; x1[i] = x1[i] * rs * gq[32 + q * 8 + i]; }
                if (SWA) {
                    const float* rt = rope + (nb * 128 + 16 * w + tl) * 16;
                    float xp[8]; unpack8(qrp, xp);
                    const float sg = (q == 0) ? -1.f : ((q == 1) ? 1.f : 0.f);
#pragma unroll
                    for (int i = 0; i < 8; ++i) {
                        const float c = (q < 2) ? rt[i] : 1.f, s = sg * rt[8 + i];
                        x0[i] = x0[i] * c + (xp[i] * rs * gq[((q ^ 1) & 1) * 8 + i]) * s;
                    }
                }
                qf[0] = as_bf16x8(pack8(x0)); qf[1] = as_bf16x8(pack8(x1));
            }
            if (hh + 1 < 4) q_load(hh + 1);
            f32x4 sacc[NKB];
#pragma unroll
            for (int kbi = 0; kbi < NKB; ++kbi) {
                sacc[kbi] = (f32x4){0.f, 0.f, 0.f, 0.f};
                const u16* kp = Kl + ((kb0 + kbi) * 16 + tl) * KL_PITCH + q * 8;
#pragma unroll
                for (int ks = 0; ks < 2; ++ks) { const bf16x8 kf = *(const bf16x8*)(kp + ks * 32); sacc[kbi] = __builtin_amdgcn_mfma_f32_16x16x32_bf16(kf, qf[ks], sacc[kbi], 0, 0, 0); }
            }
            const float sink = SWA ? p.sinks[hh] * 1.4426950408889634f : -1e30f;
            float mx = sink;
            const int qi = 16 * w + tl;
#pragma unroll
            for (int kbi = 0; kbi < NKB; ++kbi)
#pragma unroll
                for (int j = 0; j < 4; ++j) {
                    if (SWA) { const int kj = (kb0 + kbi) * 16 + q * 4 + j; const bool ok = (kj > qi) && (kj <= qi + 128) && ((nb > 0) || (kj >= 128)); if (!ok) sacc[kbi][j] = -1e30f; }
                    mx = fmaxf(mx, sacc[kbi][j]);
                }
            mx = fmaxf(mx, __shfl_xor(mx, 16)); mx = fmaxf(mx, __shfl_xor(mx, 32));
            float sum = 0.f;
#pragma unroll
            for (int kbi = 0; kbi < NKB; ++kbi)
#pragma unroll
                for (int j = 0; j < 4; ++j) { const float pe = __builtin_amdgcn_exp2f(sacc[kbi][j] - mx); sacc[kbi][j] = pe; sum += pe; }
            sum += __shfl_xor(sum, 16); sum += __shfl_xor(sum, 32);
            if (SWA) sum += __builtin_amdgcn_exp2f(sink - mx);
            const float inv = __builtin_amdgcn_rcpf(sum);
            f32x4 oacc[4];
#pragma unroll
            for (int db = 0; db < 4; ++db) oacc[db] = (f32x4){0.f, 0.f, 0.f, 0.f};
#pragma unroll
            for (int kp2 = 0; kp2 < NKB / 2; ++kp2) {
                u32x4 pw; pw.x = pk2(sacc[2 * kp2][0], sacc[2 * kp2][1]); pw.y = pk2(sacc[2 * kp2][2], sacc[2 * kp2][3]); pw.z = pk2(sacc[2 * kp2 + 1][0], sacc[2 * kp2 + 1][1]); pw.w = pk2(sacc[2 * kp2 + 1][2], sacc[2 * kp2 + 1][3]);
                const bf16x8 pf = as_bf16x8(pw);
#pragma unroll
                for (int db = 0; db < 4; ++db) {
                    const u16* vp = Vt + (db * 16 + tl) * VT_PITCH + (kb0 + 2 * kp2) * 16 + q * 4;
                    const u32x2 v0 = *(const u32x2*)vp, v1 = *(const u32x2*)(vp + 16);
                    u32x4 vw; vw.x = v0.x; vw.y = v0.y; vw.z = v1.x; vw.w = v1.y;
                    oacc[db] = __builtin_amdgcn_mfma_f32_16x16x32_bf16(as_bf16x8(vw), pf, oacc[db], 0, 0, 0);
                }
            }
#pragma unroll
            for (int db = 0; db < 4; ++db) {
                const f32x4 o = oacc[db] * inv;
                ssq += (o[0] * o[0] + o[1] * o[1]) + (o[2] * o[2] + o[3] * o[3]);
                u32x2 ow; ow.x = pk2(o[0], o[1]); ow.y = pk2(o[2], o[3]);
                *(u32x2*)(Ob + hh * 64 + db * 16) = ow;
            }
        }
    }
    ssq += __shfl_xor(ssq, 16); ssq += __shfl_xor(ssq, 32);
    const float rs = rsqrtf(ssq * (1.f / 256.f) + EPS);
#pragma unroll
    for (int i = 0; i < 16; ++i) {
        const int c = i * 16 + q * 4;
        const u32x2 ov = *(const u32x2*)(Ob + i * 16);
        const u32x2 gt = *(const u32x2*)(proj + (size_t)qrow * DIN + GCOL + c);
        const f32x4 gn = *(const f32x4*)(p.out_norm_g + YOFF + c);
        u32x2 yo; yo.x = pk2(bflo(ov.x) * rs * gn[0] * silu_f(bflo(gt.x)), bfhi(ov.x) * rs * gn[1] * silu_f(bfhi(gt.x))); yo.y = pk2(bflo(ov.y) * rs * gn[2] * silu_f(bflo(gt.y)), bfhi(ov.y) * rs * gn[3] * silu_f(bfhi(gt.y)));
        *(u32x2*)(Y + (size_t)qrow * DMIX + YOFF + c) = yo;
    }
}
__device__ __forceinline__ void phase2(const Params& p, unsigned char* lds) {
    for (int tile = blockIdx.x; tile < NBATCH * 32; tile += gridDim.x) {
        const int b = tile & 7, nb = tile >> 3;
        __syncthreads();
        p2_attn<true>(p, lds, b, nb);
        p2_attn<false>(p, lds, b, nb);
        __syncthreads();
        p2_lru(p, lds, b, nb);
    }
}

__device__ __forceinline__ void phase3(const Params& p, unsigned char* lds) {
    const int tid = fresh_tid(), lane = tid & 63, w = tid >> 6;
    const u16* proj = (const u16*)(p.ws + WS_PROJ); const u16* HL = (const u16*)(p.ws + WS_HL); const u16* PC = (const u16*)(p.ws + WS_PC); const float* AGG = (const float*)(p.ws + WS_AGG);
    u16* Y = (u16*)(p.ws + WS_Y);
    float* cl = (float*)lds;
    const int c0 = lane * 8;
    float gn[8];
#pragma unroll
    for (int i = 0; i < 8; ++i) gn[i] = p.out_norm_g[c0 + i];
    for (int tile = blockIdx.x; tile < NBATCH * 32; tile += gridDim.x) {
        const int b = tile & 7, nb = tile >> 3, tok0 = b * SEQ + nb * 128;
        {
            const float* ag = AGG + (size_t)(b * 32) * 2 * LRUW + tid;
            float cy = 0.f;
#pragma unroll 8
            for (int j = 0; j < nb; ++j) { const float pj = ag[(size_t)j * 2 * LRUW], hj = ag[(size_t)j * 2 * LRUW + LRUW]; cy = cy * pj + hj; }
            __syncthreads();
            cl[tid] = cy;
            __syncthreads();
        }
        float carry[8];
        { const f32x4 ca = *(const f32x4*)(cl + c0), cb = *(const f32x4*)(cl + c0 + 4);
#pragma unroll
          for (int i = 0; i < 4; ++i) { carry[i] = ca[i]; carry[4 + i] = cb[i]; } }
#pragma unroll 1
        for (int t4 = 0; t4 < 16; t4 += 4) {
            u32x4 hl[4], pc[4], gt[4]; float ss[4]; float h[4][8];
#pragma unroll
            for (int u = 0; u < 4; ++u) { const size_t row = (size_t)tok0 + w * 16 + t4 + u;
                hl[u] = __builtin_nontemporal_load((const u32x4*)(HL + row * LRUW + c0)); pc[u] = __builtin_nontemporal_load((const u32x4*)(PC + row * LRUW + c0)); gt[u] = __builtin_nontemporal_load((const u32x4*)(proj + row * DIN + C_LRUG + c0)); }
#pragma unroll
            for (int u = 0; u < 4; ++u) { float pf[8]; unpack8(hl[u], h[u]); unpack8(pc[u], pf); ss[u] = 0.f;
#pragma unroll
                for (int i = 0; i < 8; ++i) { h[u][i] = h[u][i] + pf[i] * carry[i]; ss[u] += h[u][i] * h[u][i]; } }
#pragma unroll
            for (int o = 1; o < 64; o <<= 1) {
#pragma unroll
                for (int u = 0; u < 4; ++u) ss[u] += __shfl_xor(ss[u], o); }
#pragma unroll
            for (int u = 0; u < 4; ++u) { const size_t row = (size_t)tok0 + w * 16 + t4 + u;
                const float rs = rsqrtf(ss[u] * (1.f / LRUW) + EPS); float gf[8], yv[8]; unpack8(gt[u], gf);
#pragma unroll
                for (int i = 0; i < 8; ++i) yv[i] = h[u][i] * rs * gn[i] * silu_f(gf[i]);
                *(u32x4*)(Y + row * DMIX + c0) = pack8(yv); }
        }
    }
}

#define XB_TMO      128
#define XB_XCNT(j)  (256  + 64 * (j))
#define XB_XSUB(j)  (1280 + 64 * (j))
#define XB_XGEN(j)  (2304 + 64 * (j))
#define XB_TOP      3328
#define XB_TOPGEN   3392
#define XCD_BAR_WORDS 3456
#define XB_SPIN_CAP (1u << 18)
#define LAS __attribute__((address_space(3)))

__device__ __forceinline__ unsigned xb_ld(unsigned* p)              { return __hip_atomic_load(p, __ATOMIC_RELAXED, __HIP_MEMORY_SCOPE_AGENT); }
__device__ __forceinline__ unsigned xb_add(unsigned* p, unsigned v) { return __hip_atomic_fetch_add(p, v, __ATOMIC_RELAXED, __HIP_MEMORY_SCOPE_AGENT); }
__device__ __forceinline__ unsigned xb_xcc_id() { return (unsigned)__builtin_amdgcn_s_getreg((3 << 11) | 20) & 0xFu; }
#define XB_SPIN(cond, bar) do { unsigned _sp = 0; while (cond) { __builtin_amdgcn_s_sleep(1); \
    if ((++_sp & 255u) == 0u) { if (xb_ld(&(bar)[XB_TMO])) break; if (_sp > XB_SPIN_CAP) { atomicAdd(&(bar)[XB_TMO], 1u); break; } } } } while (0)

struct XcdBarrier {
    unsigned* bar; unsigned x;
    volatile LAS unsigned* st;
};

__device__ __forceinline__ XcdBarrier xcd_barrier_post(unsigned* bar, volatile LAS unsigned* st) {
    XcdBarrier b; b.bar = bar; b.x = xb_xcc_id(); b.st = st;
    if (threadIdx.x == 0) (void)xb_add(&bar[XB_XCNT(b.x)], 1u);
    return b;
}
__device__ __forceinline__ void xcd_barrier_complete(unsigned* bar, unsigned x, unsigned& nloc, unsigned& nx) {
    const unsigned G = gridDim.x * gridDim.y * gridDim.z;
    unsigned sum, cnt, mine, sp = 0u;
    for (;;) {
        sum = 0u; cnt = 0u; mine = 0u;
#pragma unroll
        for (unsigned j = 0; j < 16; ++j) { const unsigned c = xb_ld(&bar[XB_XCNT(j)]); sum += c; cnt += (c > 0u) ? 1u : 0u; mine = (j == x) ? c : mine; }
        if (sum == G) break;
        __builtin_amdgcn_s_sleep(1);
        if ((++sp & 255u) == 0u) { if (xb_ld(&bar[XB_TMO])) break; if (sp > XB_SPIN_CAP) { atomicAdd(&bar[XB_TMO], 1u); break; } }
    }
    nloc = mine > 0u ? mine : 1u; nx = cnt > 0u ? cnt : 1u;
}

__device__ __forceinline__ void xcd_barrier(const XcdBarrier& b) {
    asm volatile("s_waitcnt vmcnt(0)" ::: "memory");
    __syncthreads();
    if (threadIdx.x == 0) {
        unsigned* bar = b.bar;
        __builtin_amdgcn_s_waitcnt(0);
        unsigned nloc = b.st[0], nx = b.st[1];
        if (nloc == 0u) { xcd_barrier_complete(bar, b.x, nloc, nx); b.st[0] = nloc; b.st[1] = nx; }
        const unsigned old = xb_add(&bar[XB_XSUB(b.x)], 1u);
        const unsigned gen = old / nloc;
        if (old + 1u == (gen + 1u) * nloc) {
            __builtin_amdgcn_fence(__ATOMIC_RELEASE, "agent");
            asm volatile("s_waitcnt vmcnt(0)" ::: "memory");
            const unsigned og = xb_add(&bar[XB_TOP], 1u);
            const unsigned tg = og / nx;
            if (og + 1u == (tg + 1u) * nx) xb_add(&bar[XB_TOPGEN], 1u);
            else XB_SPIN(xb_ld(&bar[XB_TOPGEN]) == tg, bar);
            __builtin_amdgcn_fence(__ATOMIC_ACQUIRE, "agent");
            xb_add(&bar[XB_XGEN(b.x)], 1u);
            asm volatile("s_waitcnt vmcnt(0)" ::: "memory");
        } else {
            XB_SPIN(xb_ld(&bar[XB_XGEN(b.x)]) == gen, bar);
            __builtin_amdgcn_fence(__ATOMIC_ACQUIRE, "agent");
            asm volatile("s_waitcnt vmcnt(0)" ::: "memory");
        }
    }
    __syncthreads();
}

__global__ void __launch_bounds__(NTHREADS, 2) k_mega(Params p) {
    extern __shared__ __attribute__((aligned(16))) unsigned char lds[];
    volatile LAS unsigned* st = (volatile LAS unsigned*)(lds + LDS_BYTES - 16);
    if (threadIdx.x < 4) st[threadIdx.x] = 0u;
    __syncthreads();
    (void)xcd_barrier_post((unsigned*)(p.ws + WS_BAR), st);
#define GRID_BAR() do { XcdBarrier b_; b_.bar = (unsigned*)(p.ws + WS_BAR); b_.x = xb_xcc_id(); b_.st = (volatile LAS unsigned*)(lds + LDS_BYTES - 16); xcd_barrier(b_); } while (0)
    phase0(p, lds); GRID_BAR();
    phase1(p, lds); GRID_BAR();
    phase2(p, lds); GRID_BAR();
    phase3(p, lds); GRID_BAR();
    phase4(p, lds);
}

extern "C" void kernel_launch(void* const* d_in, const int* in_sizes, int n_in, void* d_out, int out_size, void* d_ws, size_t ws_size, hipStream_t stream) {
    static int grid = 0;
    if (grid == 0) {
        if (n_in != 20 || out_size != T_TOK * DM || ws_size < WS_END) { fprintf(stderr, "kernel_launch: unexpected shapes (n_in %d out %d ws %zu)\n", n_in, out_size, ws_size); grid = -1; return; }
        int dev = 0, cus = 0, per_cu = 0;
        hipGetDevice(&dev); hipDeviceGetAttribute(&cus, hipDeviceAttributeMultiprocessorCount, dev);
        hipFuncSetAttribute((const void*)k_mega, hipFuncAttributeMaxDynamicSharedMemorySize, LDS_BYTES);
        hipOccupancyMaxActiveBlocksPerMultiprocessor(&per_cu, (const void*)k_mega, NTHREADS, LDS_BYTES);
        if (per_cu < 1) { fprintf(stderr, "kernel_launch: occupancy query says %d blocks per CU\n", per_cu); per_cu = 1; }
        if (per_cu > 1) per_cu = 1;
        grid = cus * per_cu;
        (void)hipGetLastError();
    }
    if (grid < 0) return;
    Params p{};
    p.x = (const float*)d_in[0]; p.mem = (const float*)d_in[1]; p.norm_g = (const float*)d_in[2]; p.mem_norm_g = (const float*)d_in[3]; p.w_in = (const float*)d_in[4];
    p.conv_w = (const float*)d_in[5]; p.conv_b = (const float*)d_in[6]; p.w_rg = (const float*)d_in[7]; p.b_rg = (const float*)d_in[8]; p.w_ig = (const float*)d_in[9]; p.b_ig = (const float*)d_in[10];
    p.lam = (const float*)d_in[11]; p.q_norm_g = (const float*)d_in[12]; p.k_norm_g = (const float*)d_in[13]; p.sinks = (const float*)d_in[14]; p.w_mem_kv = (const float*)d_in[15];
    p.xq_norm_g = (const float*)d_in[16]; p.xk_norm_g = (const float*)d_in[17]; p.out_norm_g = (const float*)d_in[18]; p.w_out = (const float*)d_in[19];
    p.out = (float*)d_out; p.ws = (unsigned char*)d_ws;
    if (hipMemsetAsync((char*)d_ws + WS_BAR, 0, 16384, stream) != hipSuccess) { fprintf(stderr, "kernel_launch: memset failed\n"); return; }
    hipLaunchKernelGGL(k_mega, dim3(grid), dim3(NTHREADS), LDS_BYTES, stream, p);
    const hipError_t e = hipPeekAtLastError();
    if (e != hipSuccess) fprintf(stderr, "launch failed: %s (grid %d)\n", hipGetErrorString(e), grid);
}
```
